# Optimizing an MI355X kernel written in HIP

```python
import jax, jax.numpy as jnp
from jax import lax
import numpy as np

D_MODEL = 2048
BATCH = 4
SEQ = 2048
DEPTH = 1
DEC_BATCH = 128
DEC_SEQ = 1
PAST_LEN = 2048
PAGE_SIZE = 128

N_HEADS = 8
HEAD_DIM = 128
KV_HEADS = 2
HPG = N_HEADS // KV_HEADS
ATTN_DIM = N_HEADS * HEAD_DIM
KV_DIM = KV_HEADS * HEAD_DIM
POOL_DIM = D_MODEL - ATTN_DIM
POOL_WINDOWS = (2, 4, 8, 16)
POOL_GROUPS = len(POOL_WINDOWS)
POOL_GW = POOL_DIM // POOL_GROUPS
POOL_BUF = max(POOL_WINDOWS) - 1
N_BRANCH = 3
PROJ_DIM = ATTN_DIM + 2 * N_BRANCH * KV_DIM + N_BRANCH * N_HEADS + POOL_DIM
ROT_DIM = HEAD_DIM // 4
ROPE_THETA = 500000.0
CMP_LEN = 32
CMP_STRIDE = 16
CMP_HID = HEAD_DIM
SEL_BLOCK = 64
SEL_TOPK = 16
WINDOW = 512
WIN_QBLK = 128
SEL_QBLK = 64
D_FF = 4 * D_MODEL
EPS = 1e-6
SCALE = HEAD_DIM ** -0.5
FORCE_SCORE = 1e4
NEG_INF = -1e30

kernel_name = 'nsa_pool_hybrid_step'


def rms_norm(x, g):
    x32 = x.astype(jnp.float32)
    y = x32 * lax.rsqrt(jnp.mean(x32 * x32, axis=-1, keepdims=True) + EPS)
    return (y * g.astype(jnp.float32)).astype(x.dtype)


def masked_softmax(s, mask):
    s = jnp.where(mask, s.astype(jnp.float32), NEG_INF)
    m = jnp.max(s, axis=-1, keepdims=True)
    e = jnp.where(mask, jnp.exp(s - m), 0.0)
    d = jnp.sum(e, axis=-1, keepdims=True)
    return e / jnp.where(d > 0, d, 1.0)


def partial_rope(x, pos):
    half = ROT_DIM // 2
    inv = jnp.power(ROPE_THETA, -jnp.arange(half, dtype=jnp.float32) * (2.0 / ROT_DIM))
    ang = pos.astype(jnp.float32)[:, None] * inv[None, :]
    cos = jnp.cos(ang)[None, :, None, :]
    sin = jnp.sin(ang)[None, :, None, :]
    x32 = x.astype(jnp.float32)
    x1, x2 = x32[..., :half], x32[..., half:ROT_DIM]
    out = jnp.concatenate([x1 * cos - x2 * sin, x1 * sin + x2 * cos, x32[..., ROT_DIM:]], axis=-1)
    return out.astype(x.dtype)


def project(h, w_in, pos):
    B, T, _ = h.shape
    z = h @ w_in
    sizes = [ATTN_DIM] + [KV_DIM] * (2 * N_BRANCH) + [N_BRANCH * N_HEADS, POOL_DIM]
    offs = np.cumsum(sizes)[:-1].tolist()
    q, kc, vc, ks, vs, kw, vw, gl, u = jnp.split(z, offs, axis=-1)
    kvh = lambda a: a.reshape(B, T, KV_HEADS, HEAD_DIM)
    q = partial_rope(q.reshape(B, T, N_HEADS, HEAD_DIM), pos)
    kc, ks, kw = partial_rope(kvh(kc), pos), partial_rope(kvh(ks), pos), partial_rope(kvh(kw), pos)
    vc, vs, vw = kvh(vc), kvh(vs), kvh(vw)
    gates = jax.nn.sigmoid(gl.astype(jnp.float32)).reshape(B, T, N_HEADS, N_BRANCH)
    return q, kc, vc, ks, vs, kw, vw, gates, u


def compress(rows, pos_emb, w1, w2):
    B, L, G, D = rows.shape
    r = CMP_LEN // CMP_STRIDE
    n_chunk = L // CMP_STRIDE
    ch = rows[:, :n_chunk * CMP_STRIDE].reshape(B, n_chunk, CMP_STRIDE, G, D)
    n_cmp = n_chunk - r + 1
    blocks = jnp.concatenate([ch[:, i:i + n_cmp] for i in range(r)], axis=2)
    blocks = blocks + pos_emb[None, None, :, None, :]
    flat = blocks.transpose(0, 1, 3, 2, 4).reshape(B, n_cmp, G, CMP_LEN * D)
    return jax.nn.gelu(flat @ w1) @ w2


def cmp_branch(q, k_rows, v_rows, q_pos, cmp_w):
    kc = compress(k_rows, *cmp_w[0])
    vc = compress(v_rows, *cmp_w[1])
    B, T = q.shape[:2]
    n_cmp = kc.shape[1]
    blk_end = jnp.arange(n_cmp) * CMP_STRIDE + CMP_LEN - 1
    mask = blk_end[None, :] <= q_pos[:, None]
    qg = q.reshape(B, T, KV_HEADS, HPG, HEAD_DIM)
    s = jnp.einsum('btghd,bngd->bghtn', qg, kc).astype(jnp.float32) * SCALE
    p = masked_softmax(s, mask)
    o = jnp.einsum('bghtn,bngd->btghd', p, vc.astype(jnp.float32))
    return o.reshape(B, T, N_HEADS, HEAD_DIM).astype(q.dtype), p


def select_blocks(p_cmp, q_pos, n_sel):
    n_cmp = p_cmp.shape[-1]
    cs = jnp.arange(n_cmp) * CMP_STRIDE
    ss = jnp.arange(n_sel) * SEL_BLOCK
    cmp_to_sel = ((cs[:, None] < ss[None, :] + SEL_BLOCK) & (cs[:, None] + CMP_LEN > ss[None, :])).astype(jnp.float32)
    imp = jnp.einsum('bghtn,ns->bgts', p_cmp, cmp_to_sel)
    j = jnp.arange(n_sel)[None, :]
    jt = (q_pos // SEL_BLOCK)[:, None]
    force = (j == 0) | (j == jt) | (j == jt - 1)
    valid = j <= jt
    score = jnp.where(force, FORCE_SCORE, jnp.where(valid, imp, -1.0))
    _, idx = lax.top_k(score, min(SEL_TOPK, n_sel))
    return idx


def to_blocks(rows, n_sel):
    B, L, G, D = rows.shape
    rows = jnp.pad(rows, ((0, 0), (0, n_sel * SEL_BLOCK - L), (0, 0), (0, 0)))
    return rows.reshape(B, n_sel, SEL_BLOCK, G, D).transpose(0, 3, 1, 2, 4)


def sel_attend(q, kb, vb, idx, q_pos):
    B, Tq = q.shape[:2]
    take = jax.vmap(jax.vmap(lambda blocks, ix: blocks[ix]))
    kg = take(kb, idx).reshape(B, KV_HEADS, Tq, -1, HEAD_DIM)
    vg = take(vb, idx).reshape(B, KV_HEADS, Tq, -1, HEAD_DIM)
    kpos = (idx[..., None] * SEL_BLOCK + jnp.arange(SEL_BLOCK)).reshape(B, KV_HEADS, Tq, -1)
    mask = (kpos <= q_pos[None, None, :, None])[:, :, None]
    qg = q.reshape(B, Tq, KV_HEADS, HPG, HEAD_DIM)
    s = jnp.einsum('btghd,bgtkd->bghtk', qg, kg).astype(jnp.float32) * SCALE
    p = masked_softmax(s, mask)
    o = jnp.einsum('bghtk,bgtkd->btghd', p, vg.astype(jnp.float32))
    return o.reshape(B, Tq, N_HEADS, HEAD_DIM).astype(q.dtype)


def sel_attend_blocked(q, kb, vb, idx, q_pos):
    B, T = q.shape[:2]
    nc = T // SEL_QBLK
    qs = q.reshape(B, nc, SEL_QBLK, N_HEADS, HEAD_DIM).swapaxes(0, 1)
    ids = idx.reshape(B, KV_HEADS, nc, SEL_QBLK, -1).transpose(2, 0, 1, 3, 4)
    ps = q_pos.reshape(nc, SEL_QBLK)
    out = lax.map(lambda a: sel_attend(a[0], kb, vb, a[1], a[2]), (qs, ids, ps))
    return out.swapaxes(0, 1).reshape(B, T, N_HEADS, HEAD_DIM)


def win_attend_band(q, k, v):
    B, T = q.shape[:2]
    nb = T // WIN_QBLK
    nprev = WINDOW // WIN_QBLK
    pad = ((0, 0), (WINDOW, 0), (0, 0), (0, 0))
    kp = jnp.pad(k, pad).reshape(B, nb + nprev, WIN_QBLK, KV_HEADS, HEAD_DIM)
    vp = jnp.pad(v, pad).reshape(B, nb + nprev, WIN_QBLK, KV_HEADS, HEAD_DIM)
    kband = jnp.concatenate([kp[:, i:i + nb] for i in range(nprev + 1)], axis=2)
    vband = jnp.concatenate([vp[:, i:i + nb] for i in range(nprev + 1)], axis=2)
    q_pos = jnp.arange(T).reshape(nb, WIN_QBLK)
    k_pos = (jnp.arange(nb) * WIN_QBLK)[:, None] - WINDOW + jnp.arange((nprev + 1) * WIN_QBLK)[None, :]
    kq = k_pos[:, None, :]
    qq = q_pos[:, :, None]
    mask = (kq <= qq) & (kq > qq - WINDOW) & (kq >= 0)
    qb = q.reshape(B, nb, WIN_QBLK, KV_HEADS, HPG, HEAD_DIM)
    s = jnp.einsum('bnqghd,bnkgd->bghnqk', qb, kband).astype(jnp.float32) * SCALE
    p = masked_softmax(s, mask)
    o = jnp.einsum('bghnqk,bnkgd->bnqghd', p, vband.astype(jnp.float32))
    return o.reshape(B, T, N_HEADS, HEAD_DIM).astype(q.dtype)


def win_attend_dense(q, k, v, q_pos, k_pos):
    B, T = q.shape[:2]
    kq = k_pos[None, :]
    qq = q_pos[:, None]
    mask = (kq <= qq) & (kq > qq - WINDOW) & (kq >= 0)
    qg = q.reshape(B, T, KV_HEADS, HPG, HEAD_DIM)
    s = jnp.einsum('btghd,bkgd->bghtk', qg, k).astype(jnp.float32) * SCALE
    p = masked_softmax(s, mask)
    o = jnp.einsum('bghtk,bkgd->btghd', p, v.astype(jnp.float32))
    return o.reshape(B, T, N_HEADS, HEAD_DIM).astype(q.dtype)


def pool_mix(u_ext, t_pos, pool_w, pool_scale):
    B, Lx, C = u_ext.shape
    T = Lx - POOL_BUF
    c = jnp.cumsum(u_ext.astype(jnp.float32), axis=1)
    c = jnp.concatenate([jnp.zeros((B, 1, C), jnp.float32), c], axis=1)
    end = c[:, POOL_BUF + 1:]
    u_new = u_ext[:, POOL_BUF:].astype(jnp.float32)
    diffs = []
    for g, w in enumerate(POOL_WINDOWS):
        lo, hi = g * POOL_GW, (g + 1) * POOL_GW
        start = c[:, POOL_BUF + 1 - w:POOL_BUF + 1 - w + T, lo:hi]
        cnt = jnp.minimum(w, t_pos + 1).astype(jnp.float32)[None, :, None]
        diffs.append((end[..., lo:hi] - start) / cnt - u_new[..., lo:hi])
    d = jnp.stack(diffs, axis=2)
    y = jnp.einsum('btgc,gce->btge', d, pool_w.astype(jnp.float32)).reshape(B, T, C)
    return (y * pool_scale.astype(jnp.float32)).astype(u_ext.dtype)


def merge(o_cmp, o_sel, o_win, gates, y_pool, w_o):
    B, T = o_cmp.shape[:2]
    o = gates[..., 0:1] * o_cmp + gates[..., 1:2] * o_sel + gates[..., 2:3] * o_win
    o = o.astype(y_pool.dtype).reshape(B, T, ATTN_DIM)
    return jnp.concatenate([o, y_pool], axis=-1) @ w_o


def mixer_prompt(h, w_in, cmp_w, pool_w, pool_scale, w_o):
    B, T, _ = h.shape
    pos = jnp.arange(T, dtype=jnp.int32)
    q, kc, vc, ks, vs, kw, vw, gates, u = project(h, w_in, pos)
    o_cmp, p_cmp = cmp_branch(q, kc, vc, pos, cmp_w)
    n_sel = -(-T // SEL_BLOCK)
    idx = select_blocks(p_cmp, pos, n_sel)
    o_sel = sel_attend_blocked(q, to_blocks(ks, n_sel), to_blocks(vs, n_sel), idx, pos)
    o_win = win_attend_band(q, kw, vw)
    u_ext = jnp.concatenate([jnp.zeros((B, POOL_BUF, POOL_DIM), u.dtype), u], axis=1)
    y_pool = pool_mix(u_ext, pos, pool_w, pool_scale)
    out = merge(o_cmp, o_sel, o_win, gates, y_pool, w_o)
    wb = min(WINDOW, T)
    kv_rows = jnp.stack([kc, vc, ks, vs], axis=2)
    win_state = jnp.stack([kw[:, T - wb:], vw[:, T - wb:]], axis=2)
    return out, kv_rows, win_state, u_ext[:, -POOL_BUF:]


def mixer_sample(h, cache_kv, win_kv, pool_state, page_table, w_in, cmp_w, pool_w, pool_scale, w_o):
    B, T, _ = h.shape
    n_pages = page_table.shape[1]
    past_len = n_pages * cache_kv.shape[1]
    pos = past_len + jnp.arange(T, dtype=jnp.int32)
    q, kc, vc, ks, vs, kw, vw, gates, u = project(h, w_in, pos)
    past = cache_kv[page_table].reshape(B, past_len, 4, KV_HEADS, HEAD_DIM)
    kc_all = jnp.concatenate([past[:, :, 0], kc], axis=1)
    vc_all = jnp.concatenate([past[:, :, 1], vc], axis=1)
    ks_all = jnp.concatenate([past[:, :, 2], ks], axis=1)
    vs_all = jnp.concatenate([past[:, :, 3], vs], axis=1)
    L = past_len + T
    o_cmp, p_cmp = cmp_branch(q, kc_all, vc_all, pos, cmp_w)
    n_sel = -(-L // SEL_BLOCK)
    idx = select_blocks(p_cmp, pos, n_sel)
    o_sel = sel_attend(q, to_blocks(ks_all, n_sel), to_blocks(vs_all, n_sel), idx, pos)
    wb = win_kv.shape[1]
    kw_all = jnp.concatenate([win_kv[:, :, 0], kw], axis=1)
    vw_all = jnp.concatenate([win_kv[:, :, 1], vw], axis=1)
    k_pos = past_len - wb + jnp.arange(wb + T, dtype=jnp.int32)
    o_win = win_attend_dense(q, kw_all, vw_all, pos, k_pos)
    u_ext = jnp.concatenate([pool_state, u], axis=1)
    y_pool = pool_mix(u_ext, pos, pool_w, pool_scale)
    out = merge(o_cmp, o_sel, o_win, gates, y_pool, w_o)
    kv_rows = jnp.stack([kc, vc, ks, vs], axis=2)
    win_state = jnp.stack([kw_all[:, -wb:], vw_all[:, -wb:]], axis=2)
    return out, kv_rows, win_state, u_ext[:, -POOL_BUF:]


def sq_relu_mlp(h, w_up, w_down):
    a = jax.nn.relu(h @ w_up)
    return (a * a) @ w_down


def setup_inputs(seed: int = 0) -> dict:
    key = jax.random.key(seed)
    ks = jax.random.split(key, 24)
    f32 = jnp.float32
    nrm = lambda k, shape, scale: jax.random.normal(k, shape, f32) * scale
    gain = lambda k: 1.0 + 0.05 * jax.random.normal(k, (DEPTH, D_MODEL), f32)
    n_pages = PAST_LEN // PAGE_SIZE
    n_used = DEC_BATCH * n_pages
    n_phys = n_used + max(1, n_used // 4)
    wb = min(WINDOW, PAST_LEN)
    page_table = jax.random.permutation(ks[5], n_phys)[:n_used].reshape(DEC_BATCH, n_pages).astype(jnp.int32)
    return {
        'x_prompt': nrm(ks[0], (BATCH, SEQ, D_MODEL), 1.0),
        'x_sample': nrm(ks[1], (DEC_BATCH, DEC_SEQ, D_MODEL), 1.0),
        'cache_kv': nrm(ks[2], (DEPTH, n_phys, PAGE_SIZE, 4, KV_HEADS, HEAD_DIM), 1.0),
        'state_win_kv': nrm(ks[3], (DEPTH, DEC_BATCH, wb, 2, KV_HEADS, HEAD_DIM), 1.0),
        'state_pool': nrm(ks[4], (DEPTH, DEC_BATCH, POOL_BUF, POOL_DIM), 1.0),
        'page_table': page_table,
        'norm_mix_pre': gain(ks[6]),
        'w_in': nrm(ks[7], (DEPTH, D_MODEL, PROJ_DIM), D_MODEL ** -0.5),
        'cmp_pos_k': nrm(ks[8], (DEPTH, CMP_LEN, HEAD_DIM), 0.1),
        'cmp_w1_k': nrm(ks[9], (DEPTH, CMP_LEN * HEAD_DIM, CMP_HID), (CMP_LEN * HEAD_DIM) ** -0.5),
        'cmp_w2_k': nrm(ks[10], (DEPTH, CMP_HID, HEAD_DIM), CMP_HID ** -0.5),
        'cmp_pos_v': nrm(ks[11], (DEPTH, CMP_LEN, HEAD_DIM), 0.1),
        'cmp_w1_v': nrm(ks[12], (DEPTH, CMP_LEN * HEAD_DIM, CMP_HID), (CMP_LEN * HEAD_DIM) ** -0.5),
        'cmp_w2_v': nrm(ks[13], (DEPTH, CMP_HID, HEAD_DIM), CMP_HID ** -0.5),
        'pool_w': nrm(ks[14], (DEPTH, POOL_GROUPS, POOL_GW, POOL_GW), POOL_GW ** -0.5),
        'pool_scale': 0.5 + 0.1 * jax.random.normal(ks[15], (DEPTH, POOL_DIM), f32),
        'w_o': nrm(ks[16], (DEPTH, D_MODEL, D_MODEL), D_MODEL ** -0.5),
        'norm_mix_post': gain(ks[17]),
        'norm_mlp_pre': gain(ks[18]),
        'w_up': nrm(ks[19], (DEPTH, D_MODEL, D_FF), D_MODEL ** -0.5),
        'w_down': nrm(ks[20], (DEPTH, D_FF, D_MODEL), D_FF ** -0.5),
        'norm_mlp_post': gain(ks[21]),
    }


def reference(x_prompt, x_sample, cache_kv, state_win_kv, state_pool, page_table,
              norm_mix_pre, w_in, cmp_pos_k, cmp_w1_k, cmp_w2_k, cmp_pos_v, cmp_w1_v, cmp_w2_v,
              pool_w, pool_scale, w_o, norm_mix_post, norm_mlp_pre, w_up, w_down, norm_mlp_post):
    y_p, y_s = x_prompt, x_sample
    kv_p, kv_s, win_p, win_s, pool_p, pool_s = [], [], [], [], [], []
    for l in range(DEPTH):
        cmp_w = ((cmp_pos_k[l], cmp_w1_k[l], cmp_w2_k[l]), (cmp_pos_v[l], cmp_w1_v[l], cmp_w2_v[l]))
        mw = (w_in[l], cmp_w, pool_w[l], pool_scale[l], w_o[l])
        m, kv_r, w_st, p_st = mixer_prompt(rms_norm(y_p, norm_mix_pre[l]), *mw)
        y_p = y_p + rms_norm(m, norm_mix_post[l])
        y_p = y_p + rms_norm(sq_relu_mlp(rms_norm(y_p, norm_mlp_pre[l]), w_up[l], w_down[l]), norm_mlp_post[l])
        kv_p.append(kv_r)
        win_p.append(w_st)
        pool_p.append(p_st)
        m, kv_r, w_st, p_st = mixer_sample(rms_norm(y_s, norm_mix_pre[l]), cache_kv[l], state_win_kv[l],
                                           state_pool[l], page_table, *mw)
        y_s = y_s + rms_norm(m, norm_mix_post[l])
        y_s = y_s + rms_norm(sq_relu_mlp(rms_norm(y_s, norm_mlp_pre[l]), w_up[l], w_down[l]), norm_mlp_post[l])
        kv_s.append(kv_r)
        win_s.append(w_st)
        pool_s.append(p_st)
    kv_prompt = jnp.stack(kv_p)
    kv_sample = jnp.stack(kv_s)
    win_prompt = jnp.stack(win_p)
    win_sample = jnp.stack(win_s)
    pool_prompt = jnp.stack(pool_p)
    pool_sample = jnp.stack(pool_s)
    return (y_p, y_s, kv_prompt, kv_sample, win_prompt, win_sample, pool_prompt, pool_sample)
```

```cpp
#include <hip/hip_runtime.h>
#include <cstdio>
#include <cstdint>

namespace pg8 {
#define PG8_LAS __attribute__((address_space(3)))
typedef unsigned short bf16_t;
typedef short bf16x8 __attribute__((ext_vector_type(8)));
typedef float f32x4 __attribute__((ext_vector_type(4)));
typedef unsigned u32x4 __attribute__((ext_vector_type(4)));
typedef unsigned u32x2 __attribute__((ext_vector_type(2)));
constexpr int BM = 256, BK = 64, HALF = 128, HTB = HALF * BK * 2  , STAGE_BYTES = 8 * HTB, NXCD = 8, WGM = 8;

__host__ __device__ __forceinline__ int lds_byte(int r, int c) { const int st = (r >> 4) * 2 + (c >> 5), rr = r & 15, cc = c & 31, ob = rr * 64 + cc * 2; return st * 1024 + (ob ^ (((ob >> 9) & 1) << 5)); }
__host__ __device__ __forceinline__ void stage_rc(int b, int& R, int& C) { const int st = b / 1024, sb = b % 1024, swz = sb ^ (((sb >> 9) & 1) << 5); R = (st >> 1) * 16 + swz / 64; C = (st & 1) * 32 + (swz % 64) / 2; }
__host__ __device__ __forceinline__ int perm32(int rho) { const int n = rho >> 4, i = rho & 15; return 8 * (i >> 2) + 4 * n + (i & 3); }

struct Unit { int pm, pn, koff; };
struct Gemm { const bf16_t* A; const bf16_t* Bt; int K, lda, ldb; };

struct StaticOrder {
    int nM, nN, nwg, G, c;
    __host__ __device__ void init(int M, int N, int G_, int c_) { nM = M / BM; nN = N / BM; nwg = nM * nN; G = G_; c = c_; }
    __host__ __device__ bool next(int i, Unit& u) const {
        const long L = (long)i * G + c; if (L >= nwg) return false;
        int wgid = (int)L; { const int q = nwg / NXCD, r = nwg % NXCD, xcd = wgid % NXCD, off = wgid / NXCD; wgid = (xcd < r ? xcd * (q + 1) : r * (q + 1) + (xcd - r) * q) + off; }
        const int nig = WGM * nN, gid = wgid / nig, fm = gid * WGM, gsz = (nM - fm) < WGM ? (nM - fm) : WGM;
        u.pm = fm + ((wgid % nig) % gsz); u.pn = (wgid % nig) / gsz; u.koff = 0; return true;
    }
    __device__ __forceinline__ void a_ready(const Unit&) const {}
    __device__ __forceinline__ void done(const Unit&) const {}
};

__device__ __forceinline__ unsigned cvt_pk_bf16(float lo, float hi) { unsigned r; asm volatile("v_cvt_pk_bf16_f32 %0, %1, %2" : "=v"(r) : "v"(lo), "v"(hi)); return r; }

template <class Epi, class Sched, bool ALIGN_EPI>
__device__ __forceinline__ void gemm_phase(PG8_LAS unsigned char* lds, const Gemm g, const Sched& S, const Epi& E) {
    const int tid = threadIdx.x, wid = __builtin_amdgcn_readfirstlane(tid >> 6), lane = tid & 63, wr = wid >> 2, wc = wid & 3, fr = lane & 15, fq = lane >> 4;
    const int K = g.K, nt = K / BK;
    unsigned voffA[2], voffB[2];
#pragma unroll
    for (int i = 0; i < 2; ++i) { int R, C; stage_rc(tid * 16 + i * 8192, R, C); const int Rb = Epi::PERM ? ((R & ~31) + perm32(R & 31)) : R;
        voffA[i] = (unsigned)(R * g.lda + C) * 2u; voffB[i] = (unsigned)(Rb * g.ldb + C) * 2u; }
    const size_t kstep = (size_t)(BK * 2);
    const size_t hstepA = (size_t)HALF * g.lda * 2, hstepB = (size_t)HALF * g.ldb * 2;
    const size_t tstepA = 2 * hstepA, tstepB = 2 * hstepB;
    const unsigned ldsw = (unsigned)wid * 1024u;
    const int aoff = lds_byte(wr * 64 + fr, fq * 8), boff = lds_byte(wc * 32 + fr, fq * 8);
#define PG8_SA(b, h) (((b) * 2 + (h)) * HTB)
#define PG8_SB(b, h) ((4 + (b) * 2 + (h)) * HTB)
#define PG8_STAGE(bufoff, gbase, voff) do { _Pragma("unroll") for (int _i = 0; _i < 2; ++_i) \
        __builtin_amdgcn_global_load_lds((const unsigned*)((const char*)(gbase) + (voff)[_i]), (PG8_LAS unsigned*)(lds + (bufoff) + ldsw + _i * 8192), 16, 0, 0); } while (0)
#define PG8_LDA(dst, b, h) do { _Pragma("unroll") for (int m = 0; m < 4; ++m) _Pragma("unroll") for (int k = 0; k < 2; ++k) dst[m][k] = *(const PG8_LAS bf16x8*)(lds + PG8_SA(b, h) + aoff + m * 2048 + k * 1024); } while (0)
#define PG8_LDB(dst, b, h) do { _Pragma("unroll") for (int n = 0; n < 2; ++n) _Pragma("unroll") for (int k = 0; k < 2; ++k) dst[n][k] = *(const PG8_LAS bf16x8*)(lds + PG8_SB(b, h) + boff + n * 2048 + k * 1024); } while (0)
#define PG8_MMA(ai, bj, At, Bt) do { __builtin_amdgcn_s_setprio(1); _Pragma("unroll") for (int m = 0; m < 4; ++m) _Pragma("unroll") for (int n = 0; n < 2; ++n) _Pragma("unroll") for (int k = 0; k < 2; ++k) \
        acc[ai][bj][m][n] = __builtin_amdgcn_mfma_f32_16x16x32_bf16(Bt[n][k], At[m][k], acc[ai][bj][m][n], 0, 0, 0); __builtin_amdgcn_s_setprio(0); } while (0)
#define PG8_WAIT_V(n) asm volatile("s_waitcnt vmcnt(" #n ")" ::: "memory")
#define PG8_WAIT_L(n) asm volatile("s_waitcnt lgkmcnt(" #n ")" ::: "memory")
#define PG8_BAR __builtin_amdgcn_s_barrier()
#define PG8_SCHED __builtin_amdgcn_sched_barrier(0)
    Unit cur, nxt; int ui = 0;
    if (!S.next(0, cur)) return;
    f32x4 acc[2][2][4][2];
#pragma unroll
    for (int a = 0; a < 2; ++a)
#pragma unroll
        for (int b = 0; b < 2; ++b)
#pragma unroll
            for (int m = 0; m < 4; ++m)
#pragma unroll
                for (int n = 0; n < 2; ++n) acc[a][b][m][n] = (f32x4){0.f, 0.f, 0.f, 0.f};
    bf16x8 At[4][2], B0[2][2], B1[2][2];
    const char* cA = (const char*)g.A + (size_t)cur.pm * tstepA + (size_t)cur.koff * 2; const char* cB = (const char*)g.Bt + (size_t)cur.pn * tstepB + (size_t)cur.koff * 2;
    S.a_ready(cur);
    PG8_STAGE(PG8_SB(0, 0), cB, voffB); PG8_STAGE(PG8_SB(0, 1), cB + hstepB, voffB); PG8_STAGE(PG8_SA(0, 0), cA, voffA); PG8_STAGE(PG8_SA(0, 1), cA + hstepA, voffA);
    if (wr == 1) PG8_BAR;
    PG8_WAIT_V(2); PG8_BAR;
    PG8_STAGE(PG8_SB(1, 0), cB + kstep, voffB); PG8_STAGE(PG8_SA(1, 0), cA + kstep, voffA); PG8_STAGE(PG8_SB(1, 1), cB + hstepB + kstep, voffB);
    PG8_WAIT_V(6); PG8_BAR;
    for (;;) {
        const bool has_next = S.next(ui + 1, nxt);
        const char* nA = has_next ? (const char*)g.A + (size_t)nxt.pm * tstepA + (size_t)nxt.koff * 2 : cA; const char* nB = has_next ? (const char*)g.Bt + (size_t)nxt.pn * tstepB + (size_t)nxt.koff * 2 : cB;
        for (int t = 0; t < nt; t += 2) {
            const bool last = (t == nt - 2);
            const char* a1 = cA + (size_t)(t + 1) * kstep;
            const char* a2 = last ? nA : cA + (size_t)(t + 2) * kstep; const char* b2 = last ? nB : cB + (size_t)(t + 2) * kstep;
            const char* a3 = a2 + kstep; const char* b3 = b2 + kstep;
            if (last && has_next) S.a_ready(nxt);
            PG8_LDB(B0, 0, 0); PG8_LDB(B1, 0, 1); PG8_SCHED; PG8_LDA(At, 0, 0); PG8_STAGE(PG8_SA(1, 1), a1 + hstepA, voffA);
            PG8_WAIT_V(8); PG8_WAIT_L(0); PG8_BAR; PG8_MMA(0, 0, At, B0); PG8_MMA(0, 1, At, B1); PG8_BAR; PG8_SCHED;
            PG8_LDA(At, 0, 1); PG8_STAGE(PG8_SB(0, 0), b2, voffB); PG8_STAGE(PG8_SB(0, 1), b2 + hstepB, voffB); PG8_STAGE(PG8_SA(0, 0), a2, voffA);
            PG8_WAIT_V(8); PG8_WAIT_L(0); PG8_BAR; PG8_MMA(1, 0, At, B0); PG8_MMA(1, 1, At, B1); PG8_BAR; PG8_SCHED;
            PG8_LDB(B0, 1, 0); PG8_LDB(B1, 1, 1); PG8_SCHED; PG8_LDA(At, 1, 0); PG8_STAGE(PG8_SA(0, 1), a2 + hstepA, voffA);
            PG8_WAIT_V(8); PG8_WAIT_L(0); PG8_BAR; PG8_MMA(0, 0, At, B0); PG8_MMA(0, 1, At, B1); PG8_BAR; PG8_SCHED;
            PG8_LDA(At, 1, 1); PG8_STAGE(PG8_SB(1, 0), b3, voffB); PG8_STAGE(PG8_SB(1, 1), b3 + hstepB, voffB); PG8_STAGE(PG8_SA(1, 0), a3, voffA);
            PG8_WAIT_V(8); PG8_WAIT_L(0); PG8_BAR; PG8_MMA(1, 0, At, B0); PG8_MMA(1, 1, At, B1); PG8_BAR; PG8_SCHED;
        }
        if constexpr (ALIGN_EPI) { if (wr == 0) PG8_BAR; }
        E(acc, cur, wr, wc, fr, fq); S.done(cur);
        if (!has_next) break;
#pragma unroll
        for (int a = 0; a < 2; ++a)
#pragma unroll
            for (int b = 0; b < 2; ++b)
#pragma unroll
                for (int m = 0; m < 4; ++m)
#pragma unroll
                    for (int n = 0; n < 2; ++n) acc[a][b][m][n] = (f32x4){0.f, 0.f, 0.f, 0.f};
        cur = nxt; cA = nA; cB = nB; ++ui;
        if constexpr (ALIGN_EPI) { if (wr == 1) PG8_BAR; }
    }
    PG8_WAIT_V(0);
    if constexpr (!ALIGN_EPI) { if (wr == 0) PG8_BAR; }
    PG8_BAR;
#undef PG8_SA
#undef PG8_SB
#undef PG8_STAGE
#undef PG8_LDA
#undef PG8_LDB
#undef PG8_MMA
#undef PG8_WAIT_V
#undef PG8_WAIT_L
#undef PG8_BAR
#undef PG8_SCHED
}
}
#define GAS __attribute__((address_space(1)))
#define LAS __attribute__((address_space(3)))
typedef unsigned short bf16;
typedef unsigned v4u __attribute__((ext_vector_type(4)));
typedef float f32x4 __attribute__((ext_vector_type(4)));
typedef short bf16x8 __attribute__((ext_vector_type(8)));
typedef GAS unsigned gu32;
typedef GAS unsigned long long gu64;
#define RLX_AGENT __ATOMIC_RELAXED, __HIP_MEMORY_SCOPE_AGENT
#define LDS_WAIT() asm volatile("s_waitcnt lgkmcnt(0)" ::: "memory")
#define VM_WAIT() asm volatile("s_waitcnt vmcnt(0)" ::: "memory")
__device__ __forceinline__ unsigned long long rt() { return __builtin_amdgcn_s_memrealtime(); }
__device__ __forceinline__ unsigned f2bf(float f) { unsigned u = __builtin_bit_cast(unsigned, f); return (u + 0x7fffu + ((u >> 16) & 1u)) >> 16; }
__device__ __forceinline__ unsigned pk2(float lo, float hi) { return f2bf(lo) | (f2bf(hi) << 16); }

#define XB_TMO      128
#define XB_XCNT(j)  (256  + 64 * (j))
#define XB_XSUB(j)  (1280 + 64 * (j))
#define XB_XGEN(j)  (2304 + 64 * (j))
#define XB_TOP      3328
#define XB_TOPGEN   3392
#define XCD_BAR_WORDS 3456
#define XB_SPIN_CAP (1u << 18)

__device__ __forceinline__ unsigned xb_ld(unsigned* p)              { return __hip_atomic_load(p, __ATOMIC_RELAXED, __HIP_MEMORY_SCOPE_AGENT); }
__device__ __forceinline__ unsigned xb_add(unsigned* p, unsigned v) { return __hip_atomic_fetch_add(p, v, __ATOMIC_RELAXED, __HIP_MEMORY_SCOPE_AGENT); }
__device__ __forceinline__ unsigned xb_xcc_id() { return (unsigned)__builtin_amdgcn_s_getreg((3 << 11) | 20) & 0xFu; }
#define XB_SPIN(cond, bar) do { unsigned _sp = 0; while (cond) { __builtin_amdgcn_s_sleep(1); \
    if ((++_sp & 255u) == 0u) { if (xb_ld(&(bar)[XB_TMO])) break; if (_sp > XB_SPIN_CAP) { atomicAdd(&(bar)[XB_TMO], 1u); break; } } } } while (0)

struct XcdBarrier {
    unsigned* bar; unsigned x;
    volatile LAS unsigned* st;
};

__device__ __forceinline__ XcdBarrier xcd_barrier_post(unsigned* bar, volatile LAS unsigned* st) {
    XcdBarrier b; b.bar = bar; b.x = xb_xcc_id(); b.st = st;
    if (threadIdx.x == 0) (void)xb_add(&bar[XB_XCNT(b.x)], 1u);
    return b;
}
__device__ __forceinline__ void xcd_barrier_complete(unsigned* bar, unsigned x, unsigned& nloc, unsigned& nx) {
    const unsigned G = gridDim.x * gridDim.y * gridDim.z;
    unsigned sum, cnt, mine, sp = 0u;
    for (;;) {
        sum = 0u; cnt = 0u; mine = 0u;
#pragma unroll
        for (unsigned j = 0; j < 16; ++j) { const unsigned c = xb_ld(&bar[XB_XCNT(j)]); sum += c; cnt += (c > 0u) ? 1u : 0u; mine = (j == x) ? c : mine; }
        if (sum == G) break;
        __builtin_amdgcn_s_sleep(1);
        if ((++sp & 255u) == 0u) { if (xb_ld(&bar[XB_TMO])) break; if (sp > XB_SPIN_CAP) { atomicAdd(&bar[XB_TMO], 1u); break; } }
    }
    nloc = mine > 0u ? mine : 1u; nx = cnt > 0u ? cnt : 1u;
}

__device__ __forceinline__ void xcd_barrier(const XcdBarrier& b) {
    asm volatile("s_waitcnt vmcnt(0)" ::: "memory");
    __syncthreads();
    if (threadIdx.x == 0) {
        unsigned* bar = b.bar;
        __builtin_amdgcn_s_waitcnt(0);
        unsigned nloc = b.st[0], nx = b.st[1];
        if (nloc == 0u) { xcd_barrier_complete(bar, b.x, nloc, nx); b.st[0] = nloc; b.st[1] = nx; }
        const unsigned old = xb_add(&bar[XB_XSUB(b.x)], 1u);
        const unsigned gen = old / nloc;
        if (old + 1u == (gen + 1u) * nloc) {
            __builtin_amdgcn_fence(__ATOMIC_RELEASE, "agent");
            asm volatile("s_waitcnt vmcnt(0)" ::: "memory");
            const unsigned og = xb_add(&bar[XB_TOP], 1u);
            const unsigned tg = og / nx;
            if (og + 1u == (tg + 1u) * nx) xb_add(&bar[XB_TOPGEN], 1u);
            else XB_SPIN(xb_ld(&bar[XB_TOPGEN]) == tg, bar);
            __builtin_amdgcn_fence(__ATOMIC_ACQUIRE, "agent");
            xb_add(&bar[XB_XGEN(b.x)], 1u);
            asm volatile("s_waitcnt vmcnt(0)" ::: "memory");
        } else {
            XB_SPIN(xb_ld(&bar[XB_XGEN(b.x)]) == gen, bar);
            __builtin_amdgcn_fence(__ATOMIC_ACQUIRE, "agent");
            asm volatile("s_waitcnt vmcnt(0)" ::: "memory");
        }
    }
    __syncthreads();
}


constexpr int NWAVES = 8, NTHREADS = 512;
constexpr int DM = 2048, NPTOK = 8192, SEQ = 2048, NB = 4, NS = 128, MTOK = NPTOK + NS  , MROWS = 8448  ;
constexpr int NPROJ = 3608, NPROJ_PAD = 3840, DFF = 8192;
constexpr int NHEAD = 8, HD = 128, NG = 2, HPG = 4;
constexpr int NCMP = 127, NSEL_P = 32, NSEL_S = 33, TOPK = 16;
constexpr int NPAGES = 16, PAGE = 128, PAST = 2048, WB = 512;
constexpr float EPS = 1e-6f;
constexpr float SM_SCALE = 0.08838834764831845f;
constexpr float SM_C2 = SM_SCALE * 1.4426950408889634f;

constexpr size_t O_YP = 0, O_YS = O_YP + (size_t)NPTOK * DM, O_KVP = O_YS + (size_t)NS * DM, O_KVS = O_KVP + (size_t)NPTOK * 1024,
                 O_WINP = O_KVS + (size_t)NS * 1024, O_WINS = O_WINP + (size_t)NB * 512 * 512, O_POOLP = O_WINS + (size_t)NS * 512 * 512,
                 O_POOLS = O_POOLP + (size_t)NB * 15 * 1024, O_END = O_POOLS + (size_t)NS * 15 * 1024;

constexpr size_t MiB = 1u << 20;
constexpr size_t WS_CTL = 0, CTL_ZERO_BYTES = 1 * MiB;
constexpr size_t WS_WIN_T = 2 * MiB;
constexpr size_t WS_WO_T = 18 * MiB;
constexpr size_t WS_WUP_T = 26 * MiB;
constexpr size_t WS_WDN_T = 58 * MiB;
constexpr size_t WS_WC1_T = 90 * MiB;
constexpr size_t WS_WC2_T = 92 * MiB;
constexpr size_t WS_POOLW_T = 92 * MiB + 256 * 1024;
constexpr size_t WS_ROPE = 93 * MiB;
constexpr size_t WS_XN = 96 * MiB;
constexpr size_t WS_Q = 130 * MiB;
constexpr size_t WS_KCP = 148 * MiB;
constexpr size_t WS_KS = 156 * MiB;
constexpr size_t WS_VST = 160 * MiB;
constexpr size_t WS_KW = 164 * MiB;
constexpr size_t WS_VWT = 168 * MiB;
constexpr size_t WS_U = 172 * MiB;
constexpr size_t WS_GATES = 190 * MiB;
constexpr size_t WS_TBP = 760 * MiB;
constexpr size_t WS_CMPP = 195 * MiB;
constexpr size_t WS_CMPS = 196 * MiB;
constexpr size_t WS_TBS = 216 * MiB;
constexpr size_t WS_CA = 256 * MiB;
constexpr size_t WS_CONCAT = 520 * MiB;
constexpr size_t WS_M = 556 * MiB;
constexpr size_t WS_ACT = 624 * MiB;
constexpr size_t WS_CBPART = 776 * MiB;
constexpr size_t WS_CBIAS = 776 * MiB + 128 * 1024;
constexpr size_t WS_SSP = 777 * MiB;
constexpr size_t WS_END = 780 * MiB;
constexpr int CW_TMO = 0, CW_CODE = 1;
constexpr int CW_BAR = 4096;
constexpr int CW_Q3 = 8192;
constexpr int CW_CBIAS = 8448;
constexpr int CW_SS1 = 16384;
constexpr int CW_SS2 = 32768;
static_assert((CW_SS2 + MROWS) * 4 <= (int)CTL_ZERO_BYTES, "CTL");

constexpr int RING_OFF = 0, RING_BYTES = 131072;
constexpr int LDSCTL_OFF = RING_BYTES, MISC_OFF = LDSCTL_OFF + 320;
constexpr int LDS_BYTES = 147456;

typedef unsigned u32x2v __attribute__((ext_vector_type(2)));
typedef float f32x2v __attribute__((ext_vector_type(2)));
struct Args { const float* in[22]; float* out; unsigned char* ws; int ph_lo, ph_hi; };
struct Frame {
    LAS unsigned char* lds;
    volatile LAS unsigned* MISC;
    gu32* ctl;
    unsigned char* ws;
    float* out;
    int tid, lane, wave;
    int vcu, G;
};

__device__ __forceinline__ float wave_sum(float v) {
#pragma unroll
    for (int o = 1; o < 64; o <<= 1) v += __shfl_xor(v, o);
    return v;
}
typedef __bf16 bf16x2_t __attribute__((ext_vector_type(2)));
__device__ __forceinline__ unsigned cvtpk(float lo, float hi) { const f32x2v v = {lo, hi}; const bf16x2_t b = __builtin_convertvector(v, bf16x2_t); return __builtin_bit_cast(unsigned, b); }
__device__ __forceinline__ float bf_lo(unsigned w) { return __uint_as_float(w << 16); }
__device__ __forceinline__ float bf_hi(unsigned w) { return __uint_as_float(w & 0xffff0000u); }
__device__ __forceinline__ float bf2f(bf16 h) { return __uint_as_float(((unsigned)h) << 16); }

template <int MODE>
__device__ __forceinline__ void p0_transpose_item(const float* W, int N, int ldw, bf16* WT, int ldt, int row_off, const float* gain, LAS float* scr, int item, int lane) {
    const int nblk = (N + 31) / 32, kb = item / nblk, nb = item % nblk, k0 = 64 * kb, n0 = 32 * nb;
    const int nn = n0 + (lane & 31);
#pragma unroll
    for (int i = 0; i < 32; ++i) { const int kk = 2 * i + (lane >> 5); float v = (nn < N) ? W[(size_t)(k0 + kk) * ldw + nn] : 0.f; if (gain) v *= gain[k0 + kk]; scr[kk * 33 + (lane & 31)] = v; }
    LDS_WAIT(); asm volatile("" ::: "memory");
    const int c = lane & 7;
#pragma unroll
    for (int j = 0; j < 4; ++j) { const int nl = (lane >> 3) + 8 * j, n = n0 + nl; const LAS float* s = scr + (8 * c) * 33 + nl;
        if (n < N) {
            int dest = n;
            if (MODE == 1) dest = (n < 2560) ? n : ((n < 2584) ? (3584 + (n - 2560)) : (n - 24));
            v4u o; o.x = cvtpk(s[0 * 33], s[1 * 33]); o.y = cvtpk(s[2 * 33], s[3 * 33]); o.z = cvtpk(s[4 * 33], s[5 * 33]); o.w = cvtpk(s[6 * 33], s[7 * 33]);
            *(v4u*)(WT + (size_t)(row_off + dest) * ldt + k0 + 8 * c) = o; } }
    LDS_WAIT(); asm volatile("" ::: "memory");
}

__device__ __forceinline__ void p0_prologue(Frame& F, const Args& A) {
    LAS float* scr = (LAS float*)(F.lds + RING_OFF + F.wave * 16384);
    const int gw = F.vcu * NWAVES + F.wave, NGW = F.G * NWAVES;
    const int gt = F.vcu * NTHREADS + F.tid, NGT = F.G * NTHREADS;
    unsigned char* ws = F.ws;
    {
        constexpr int I_IN = 32 * 113, I_O = 32 * 64, I_UP = 32 * 256, I_DN = 128 * 64, I_C1 = 32 * 4, I_C2 = 2 * 4, I_PW = 4 * 8;
        constexpr int NITEMS = I_IN + I_O + I_UP + I_DN + 4 * I_C1 + 2 * I_C2 + 4 * I_PW;
        for (int it = gw; it < NITEMS; it += NGW) {
            int r = it;
            if (r < I_IN) { p0_transpose_item<1>(A.in[7], NPROJ, NPROJ, (bf16*)(ws + WS_WIN_T), DM, 0, A.in[6], scr, r, F.lane); continue; } r -= I_IN;
            if (r < I_O) { p0_transpose_item<0>(A.in[16], DM, DM, (bf16*)(ws + WS_WO_T), DM, 0, nullptr, scr, r, F.lane); continue; } r -= I_O;
            if (r < I_UP) { p0_transpose_item<0>(A.in[19], DFF, DFF, (bf16*)(ws + WS_WUP_T), DM, 0, A.in[18], scr, r, F.lane); continue; } r -= I_UP;
            if (r < I_DN) { p0_transpose_item<0>(A.in[20], DM, DM, (bf16*)(ws + WS_WDN_T), DFF, 0, nullptr, scr, r, F.lane); continue; } r -= I_DN;
            if (r < 4 * I_C1) { const int kind = r / (2 * I_C1), half = (r / I_C1) & 1, rr = r % I_C1;
                p0_transpose_item<0>(A.in[kind ? 12 : 9] + (size_t)half * 2048 * 128, 128, 128, (bf16*)(ws + WS_WC1_T) + (size_t)kind * 256 * 2048, 2048, half * 128, nullptr, scr, rr, F.lane); continue; } r -= 4 * I_C1;
            if (r < 2 * I_C2) { const int kind = r / I_C2, rr = r % I_C2;
                p0_transpose_item<0>(A.in[kind ? 13 : 10], 128, 128, (bf16*)(ws + WS_WC2_T) + (size_t)kind * 128 * 128, 128, 0, nullptr, scr, rr, F.lane); continue; } r -= 2 * I_C2;
            { const int g = r / I_PW, rr = r % I_PW;
                p0_transpose_item<0>(A.in[14] + (size_t)g * 256 * 256, 256, 256, (bf16*)(ws + WS_POOLW_T) + (size_t)g * 256 * 256, 256, 0, nullptr, scr, rr, F.lane); }
        }
    }
    { v4u z = {0u, 0u, 0u, 0u};
      v4u* p = (v4u*)(ws + WS_WIN_T + (size_t)NPROJ * DM * 2); const int n1 = (NPROJ_PAD - NPROJ) * DM * 2 / 16;
      for (int i = gt; i < n1; i += NGT) p[i] = z;
      v4u* xz = (v4u*)(ws + WS_XN + (size_t)MTOK * DM * 2); const int n3 = (MROWS - MTOK) * DM * 2 / 16;
      for (int i = gt; i < n3; i += NGT) xz[i] = z; }
    for (int m = gw; m < MTOK; m += NGW) {
        const float* xrow = (m < NPTOK) ? A.in[0] + (size_t)m * DM : A.in[1] + (size_t)(m - NPTOK) * DM;
        const f32x4* xr = (const f32x4*)xrow + F.lane;
        f32x4 v[8]; float s = 0.f;
#pragma unroll
        for (int j = 0; j < 8; ++j) { v[j] = xr[64 * j]; s += (v[j].x * v[j].x + v[j].y * v[j].y) + (v[j].z * v[j].z + v[j].w * v[j].w); }
        const float rstd = 1.f / sqrtf(wave_sum(s) * (1.f / DM) + EPS);
        u32x2v* o8 = (u32x2v*)((bf16*)(ws + WS_XN) + (size_t)m * DM) + F.lane;
#pragma unroll
        for (int j = 0; j < 8; ++j) { u32x2v w; w.x = cvtpk(v[j].x * rstd, v[j].y * rstd); w.y = cvtpk(v[j].z * rstd, v[j].w * rstd); o8[64 * j] = w; }
    }
    { float* rope = (float*)(ws + WS_ROPE);
      for (int i = gt; i < 2049 * 16; i += NGT) { const int pos = i >> 4, k = i & 15;
          const float inv = exp2f(-(float)k * (18.931568569324174f / 16.f));
          const float ang = (float)pos * inv;
          const float kk = rintf(ang * 0.15915494309189535f);
          float r = fmaf(-kk, 6.28125f, ang); r = fmaf(-kk, 1.9353071795864769e-3f, r);
          rope[pos * 32 + k] = __cosf(r); rope[pos * 32 + 16 + k] = __sinf(r); } }
    if (F.vcu < 32) { const int kind = F.vcu >> 4, kc = F.vcu & 15, n = F.tid & 127, kq = F.tid >> 7;
        const float* pe = A.in[kind ? 11 : 8]; const float* w1 = A.in[kind ? 12 : 9];
        float s = 0.f; const int kbeg = kc * 256 + kq * 64;
#pragma unroll 8
        for (int k = kbeg; k < kbeg + 64; ++k) s += pe[k] * w1[(size_t)k * 128 + n];
        ((float*)(ws + WS_CBPART))[(kind * 64 + kc * 4 + kq) * 128 + n] = s; }
    { const int* pt = (const int*)A.in[5]; const float* cache = A.in[2]; bf16* CA = (bf16*)(ws + WS_CA);
      const int seg = F.lane >> 4, kind = seg >> 1, g = seg & 1, d0 = (F.lane & 15) * 8;
      for (int it0 = gw; it0 < NS * PAST; it0 += 4 * NGW) {
          f32x4 a[4], b[4]; int prow[4];
#pragma unroll
          for (int u = 0; u < 4; ++u) { const int it = it0 + u * NGW; const int s = it >> 11, pos = it & 2047; prow[u] = (it < NS * PAST) ? pt[s * NPAGES + (pos >> 7)] * PAGE + (pos & 127) : 0; }
#pragma unroll
          for (int u = 0; u < 4; ++u) { const f32x4* src = (const f32x4*)(cache + (size_t)prow[u] * 1024 + F.lane * 8); a[u] = src[0]; b[u] = src[1]; }
#pragma unroll
          for (int u = 0; u < 4; ++u) { const int it = it0 + u * NGW; const int s = it >> 11, pos = it & 2047;
              v4u o; o.x = cvtpk(a[u].x, a[u].y); o.y = cvtpk(a[u].z, a[u].w); o.z = cvtpk(b[u].x, b[u].y); o.w = cvtpk(b[u].z, b[u].w);
              if (it < NS * PAST) *(v4u*)(CA + (size_t)kind * 32768 * 2048 + (size_t)(s * 2 + g) * 262144 + (size_t)pos * 128 + d0) = o; } } }
    { const f32x4* sp = (const f32x4*)A.in[4]; f32x4* po = (f32x4*)(F.out + O_POOLS);
      for (int i = gt; i < NS * 14 * 256; i += NGT) { const int s = i / (14 * 256), r = i % (14 * 256); po[s * 15 * 256 + r] = sp[s * 15 * 256 + 256 + r]; } }
}

using pg8::Unit;
using pg8::cvt_pk_bf16;
struct EpiProj {
    static constexpr bool PERM = false;
    unsigned char* ws; float* out; const float* rope;
    __device__ __forceinline__ void operator()(const f32x4 (&acc)[2][2][4][2], const Unit& u, int wr, int wc, int fr, int fq) const {
        const int pn = u.pn;
        const bool roped = (pn < 4) || pn == 4 || pn == 6 || pn == 8;
#pragma unroll
        for (int ai = 0; ai < 2; ++ai)
#pragma unroll
            for (int m = 0; m < 4; ++m) {
                const int row = u.pm * 256 + ai * 128 + wr * 64 + m * 16 + fr;
                if (row >= MTOK) continue;
                const bool prompt = row < NPTOK;
                const int b = row >> 11, t = row & 2047, s = row - NPTOK, pos = prompt ? t : PAST;
                f32x4 cs = {1.f, 1.f, 1.f, 1.f}, sn = {0.f, 0.f, 0.f, 0.f};
                if (roped && wc == 0) { cs = *(const f32x4*)(rope + pos * 32 + 4 * fq); sn = *(const f32x4*)(rope + pos * 32 + 16 + 4 * fq); }
#pragma unroll
                for (int bj = 0; bj < 2; ++bj) {
                    f32x4 v0 = acc[ai][bj][m][0], v1 = acc[ai][bj][m][1];
                    if (roped && wc == 0) { const f32x4 a = v0 * cs - v1 * sn, c = v0 * sn + v1 * cs; v0 = a; v1 = c; }
                    const int d0 = wc * 32 + 4 * fq;
                    if (pn < 4) {
                        bf16* q = (bf16*)(ws + WS_Q) + (size_t)row * 1024 + pn * 256 + bj * 128 + d0;
                        u32x2v w0, w1; w0.x = cvtpk(v0[0], v0[1]); w0.y = cvtpk(v0[2], v0[3]); w1.x = cvtpk(v1[0], v1[1]); w1.y = cvtpk(v1[2], v1[3]);
                        *(u32x2v*)q = w0; *(u32x2v*)(q + 16) = w1;
                    } else if (pn < 8) {
                        const int slot = pn - 4;
                        float* o = out + (prompt ? O_KVP + (size_t)row * 1024 : O_KVS + (size_t)s * 1024) + slot * 256 + bj * 128 + d0;
                        *(f32x4*)o = v0; *(f32x4*)(o + 16) = v1;
                        if (prompt) {
                            if (pn == 4 || pn == 5) {
                                bf16* p = (bf16*)(ws + WS_KCP) + (size_t)(pn - 4) * (NB * NG * SEQ * 128) + ((size_t)(b * NG + bj) * SEQ + t) * 128 + d0;
                                u32x2v w0, w1; w0.x = cvtpk(v0[0], v0[1]); w0.y = cvtpk(v0[2], v0[3]); w1.x = cvtpk(v1[0], v1[1]); w1.y = cvtpk(v1[2], v1[3]);
                                *(u32x2v*)p = w0; *(u32x2v*)(p + 16) = w1;
                            } else if (pn == 6) {
                                bf16* p = (bf16*)(ws + WS_KS) + ((size_t)(b * NG + bj) * SEQ + t) * 128 + d0;
                                u32x2v w0, w1; w0.x = cvtpk(v0[0], v0[1]); w0.y = cvtpk(v0[2], v0[3]); w1.x = cvtpk(v1[0], v1[1]); w1.y = cvtpk(v1[2], v1[3]);
                                *(u32x2v*)p = w0; *(u32x2v*)(p + 16) = w1;
                            } else {
                                bf16* p = (bf16*)(ws + WS_VST) + ((size_t)(b * NG + bj) * 128 + d0) * SEQ + t;
#pragma unroll
                                for (int j = 0; j < 4; ++j) { p[(size_t)j * SEQ] = (bf16)(cvtpk(v0[j], 0.f) & 0xffffu); p[(size_t)(16 + j) * SEQ] = (bf16)(cvtpk(v1[j], 0.f) & 0xffffu); }
                            }
                        }
                    } else if (pn < 10) {
                        const int kv = pn - 8;
                        if (prompt) {
                            if (t >= SEQ - WB) { float* o = out + O_WINP + ((size_t)(b * WB + (t - (SEQ - WB))) * 2 + kv) * 256 + bj * 128 + d0; *(f32x4*)o = v0; *(f32x4*)(o + 16) = v1; }
                            if (kv == 0) {
                                bf16* p = (bf16*)(ws + WS_KW) + ((size_t)(b * NG + bj) * SEQ + t) * 128 + d0;
                                u32x2v w0, w1; w0.x = cvtpk(v0[0], v0[1]); w0.y = cvtpk(v0[2], v0[3]); w1.x = cvtpk(v1[0], v1[1]); w1.y = cvtpk(v1[2], v1[3]);
                                *(u32x2v*)p = w0; *(u32x2v*)(p + 16) = w1;
                            } else {
                                bf16* p = (bf16*)(ws + WS_VWT) + ((size_t)(b * NG + bj) * 128 + d0) * SEQ + t;
#pragma unroll
                                for (int j = 0; j < 4; ++j) { p[(size_t)j * SEQ] = (bf16)(cvtpk(v0[j], 0.f) & 0xffffu); p[(size_t)(16 + j) * SEQ] = (bf16)(cvtpk(v1[j], 0.f) & 0xffffu); }
                            }
                        } else {
                            float* o = out + O_WINS + ((size_t)(s * WB + (WB - 1)) * 2 + kv) * 256 + bj * 128 + d0; *(f32x4*)o = v0; *(f32x4*)(o + 16) = v1;
                        }
                    } else if (pn < 14) {
                        const int cu = (pn - 10) * 256 + bj * 128 + d0;
                        bf16* p = (bf16*)(ws + WS_U) + (size_t)row * 1024 + cu;
                        u32x2v w0, w1; w0.x = cvtpk(v0[0], v0[1]); w0.y = cvtpk(v0[2], v0[3]); w1.x = cvtpk(v1[0], v1[1]); w1.y = cvtpk(v1[2], v1[3]);
                        *(u32x2v*)p = w0; *(u32x2v*)(p + 16) = w1;
                        if (prompt) { if (t >= SEQ - 15) { float* o = out + O_POOLP + (size_t)(b * 15 + (t - (SEQ - 15))) * 1024 + cu; *(f32x4*)o = v0; *(f32x4*)(o + 16) = v1; } }
                        else { float* o = out + O_POOLS + (size_t)(s * 15 + 14) * 1024 + cu; *(f32x4*)o = v0; *(f32x4*)(o + 16) = v1; }
                    } else {
                        if (bj == 0 && wc == 0) {
                            float* gp = (float*)(ws + WS_GATES) + (size_t)row * 24 + 4 * fq;
                            f32x4 s0;
#pragma unroll
                            for (int j = 0; j < 4; ++j) s0[j] = 1.f / (1.f + __expf(-v0[j]));
                            *(f32x4*)gp = s0;
                            if (fq < 2) { f32x4 s1;
#pragma unroll
                                for (int j = 0; j < 4; ++j) s1[j] = 1.f / (1.f + __expf(-v1[j]));
                                *(f32x4*)(gp + 16) = s1; }
                        }
                    }
                }
            }
    }
};
struct EpiCmpS {
    static constexpr bool PERM = true;
    bf16* O;
    __device__ __forceinline__ void operator()(const f32x4 (&acc)[2][2][4][2], const Unit& u, int wr, int wc, int fr, int fq) const {
#pragma unroll
        for (int ai = 0; ai < 2; ++ai)
#pragma unroll
            for (int m = 0; m < 4; ++m) { const int row = u.pm * 256 + ai * 128 + wr * 64 + m * 16 + fr; bf16* rowp = O + (size_t)row * 256 + wc * 32 + 8 * fq;
#pragma unroll
                for (int bj = 0; bj < 2; ++bj) { const f32x4 v0 = acc[ai][bj][m][0], v1 = acc[ai][bj][m][1];
                    v4u w; w.x = cvtpk(v0[0], v0[1]); w.y = cvtpk(v0[2], v0[3]); w.z = cvtpk(v1[0], v1[1]); w.w = cvtpk(v1[2], v1[3]);
                    *(v4u*)(rowp + bj * 128) = w; } }
    }
};
struct CmpSOrder {
    int G, c;
    __device__ bool next(int i, Unit& u) const { const int L = i * G + c; if (L >= 256) return false; u.pm = L; u.pn = L >> 7; u.koff = 0; return true; }
    __device__ __forceinline__ void a_ready(const Unit&) const {}
    __device__ __forceinline__ void done(const Unit&) const {}
};
struct EpiCmpP {
    static constexpr bool PERM = false;
    float* O;
    __device__ __forceinline__ void operator()(const f32x4 (&acc)[2][2][4][2], const Unit& u, int wr, int wc, int fr, int fq) const {
        float* base = O + (size_t)(u.koff >> 8) * (2048 * 256);
#pragma unroll
        for (int ai = 0; ai < 2; ++ai)
#pragma unroll
            for (int m = 0; m < 4; ++m) { const int row = u.pm * 256 + ai * 128 + wr * 64 + m * 16 + fr; float* rowp = base + (size_t)row * 256 + wc * 32 + 4 * fq;
#pragma unroll
                for (int bj = 0; bj < 2; ++bj)
#pragma unroll
                    for (int n = 0; n < 2; ++n) *(f32x4*)(rowp + bj * 128 + n * 16) = acc[ai][bj][m][n]; }
    }
};
struct CmpPOrder {
    int G, c;
    __device__ bool next(int i, Unit& u) const { const int L = i * G + c; if (L >= 64) return false; u.pm = L >> 3; u.pn = L >> 5; u.koff = (L & 7) * 256; return true; }
    __device__ __forceinline__ void a_ready(const Unit&) const {}
    __device__ __forceinline__ void done(const Unit&) const {}
};
struct EpiF32SS {
    static constexpr bool PERM = false;
    float* C; float* ss;
    __device__ __forceinline__ void operator()(const f32x4 (&acc)[2][2][4][2], const Unit& u, int wr, int wc, int fr, int fq) const {
#pragma unroll
        for (int ai = 0; ai < 2; ++ai)
#pragma unroll
            for (int m = 0; m < 4; ++m) { const int row = u.pm * 256 + ai * 128 + wr * 64 + m * 16 + fr; float* rowp = C + (size_t)row * DM + u.pn * 256 + wc * 32 + 4 * fq;
                float q = 0.f;
#pragma unroll
                for (int bj = 0; bj < 2; ++bj)
#pragma unroll
                    for (int n = 0; n < 2; ++n) { const f32x4 v = acc[ai][bj][m][n]; *(f32x4*)(rowp + bj * 128 + n * 16) = v; q += (v[0] * v[0] + v[1] * v[1]) + (v[2] * v[2] + v[3] * v[3]); }
                q += __shfl_xor(q, 16); q += __shfl_xor(q, 32);
                if (fq == 0) ss[(size_t)row * 32 + u.pn * 4 + wc] = q; }
    }
};
struct EpiUp {
    static constexpr bool PERM = true;
    bf16* O;
    __device__ __forceinline__ void operator()(const f32x4 (&acc)[2][2][4][2], const Unit& u, int wr, int wc, int fr, int fq) const {
#pragma unroll
        for (int ai = 0; ai < 2; ++ai)
#pragma unroll
            for (int m = 0; m < 4; ++m) { const int row = u.pm * 256 + ai * 128 + wr * 64 + m * 16 + fr; bf16* rowp = O + (size_t)row * DFF + u.pn * 256 + wc * 32 + 8 * fq;
#pragma unroll
                for (int bj = 0; bj < 2; ++bj) { f32x4 v0 = acc[ai][bj][m][0], v1 = acc[ai][bj][m][1];
#pragma unroll
                    for (int j = 0; j < 4; ++j) { const float a = fmaxf(v0[j], 0.f), c = fmaxf(v1[j], 0.f); v0[j] = a * a; v1[j] = c * c; }
                    v4u w; w.x = cvtpk(v0[0], v0[1]); w.y = cvtpk(v0[2], v0[3]); w.z = cvtpk(v1[0], v1[1]); w.w = cvtpk(v1[2], v1[3]);
                    *(v4u*)(rowp + bj * 128) = w; } }
    }
};

typedef short s16x4 __attribute__((ext_vector_type(4)));
__device__ __forceinline__ f32x4 mfma16(bf16x8 a, bf16x8 b, f32x4 c) { return __builtin_amdgcn_mfma_f32_16x16x32_bf16(a, b, c, 0, 0, 0); }

constexpr int PL_ROW = 528;
__device__ __forceinline__ void pool_phase(Frame& F, const Args& A) {
    LAS unsigned char* dl = F.lds + RING_OFF;
    const bf16* U = (const bf16*)(F.ws + WS_U); const bf16* PW = (const bf16*)(F.ws + WS_POOLW_T); bf16* CC = (bf16*)(F.ws + WS_CONCAT);
    const float* spool = A.in[4]; const float* pscale = A.in[15];
    int tid_ = F.tid; asm volatile("" : "+v"(tid_));
    const int lane = tid_ & 63, idx = lane & 15, q = lane >> 4, wm = F.wave & 3, wn = F.wave >> 2;
    for (int unit = F.vcu; unit < 130 * 4; unit += F.G) {
        const int tt = unit >> 2, g = unit & 3, w = 2 << g, row0 = tt * 64;
        {
            const int c = tid_ & 255, half = tid_ >> 8, rfirst = row0 + half * 32;
            const bf16* ucol = U + g * 256 + c;
            if (row0 < NPTOK) {
                const int tfirst = rfirst & 2047;
                float sum = 0.f;
                for (int j = 1; j < w; ++j) if (tfirst - j >= 0) sum += bf2f(ucol[(size_t)(rfirst - j) * 1024]);
                for (int i = 0; i < 32; ++i) { const int t = tfirst + i, r = rfirst + i;
                    const float uv = bf2f(ucol[(size_t)r * 1024]); sum += uv;
                    const int cnt = (t + 1 < w) ? (t + 1) : w;
                    const float d = sum / (float)cnt - uv;
                    *(LAS bf16*)(dl + (half * 32 + i) * PL_ROW + c * 2) = (bf16)(cvtpk(d, 0.f) & 0xffffu);
                    if (t - w + 1 >= 0) sum -= bf2f(ucol[(size_t)(r - w + 1) * 1024]); }
            } else {
                for (int i = 0; i < 32; ++i) { const int s = rfirst - NPTOK + i;
                    const float uv = bf2f(ucol[(size_t)(NPTOK + s) * 1024]); float sum = uv;
                    for (int j = 0; j < w - 1; ++j) sum += spool[((size_t)s * 15 + 14 - j) * 1024 + g * 256 + c];
                    const float d = sum / (float)w - uv;
                    *(LAS bf16*)(dl + (half * 32 + i) * PL_ROW + c * 2) = (bf16)(cvtpk(d, 0.f) & 0xffffu); }
            }
        }
        __syncthreads();
        {
            f32x4 acc[8];
#pragma unroll
            for (int nt = 0; nt < 8; ++nt) acc[nt] = (f32x4){0.f, 0.f, 0.f, 0.f};
            const bf16* pwb = PW + ((size_t)g * 256 + 128 * wn + idx) * 256 + 8 * q;
#pragma unroll 2
            for (int ks = 0; ks < 8; ++ks) {
                const bf16x8 df = *(const LAS bf16x8*)(dl + (16 * wm + idx) * PL_ROW + (32 * ks + 8 * q) * 2);
#pragma unroll
                for (int nt = 0; nt < 8; ++nt) { const bf16x8 wf = *(const bf16x8*)(pwb + (size_t)(16 * nt) * 256 + 32 * ks); acc[nt] = mfma16(wf, df, acc[nt]); }
            }
            const int row = row0 + 16 * wm + idx;
            if (row < MTOK) {
#pragma unroll
                for (int nt = 0; nt < 8; ++nt) { const int e = 128 * wn + 16 * nt + 4 * q; const f32x4 sc = *(const f32x4*)(pscale + g * 256 + e);
                    u32x2v o; o.x = cvtpk(acc[nt][0] * sc[0], acc[nt][1] * sc[1]); o.y = cvtpk(acc[nt][2] * sc[2], acc[nt][3] * sc[3]);
                    *(u32x2v*)(CC + (size_t)row * DM + 1024 + g * 256 + e) = o; }
            }
        }
        __syncthreads();
    }
}

__device__ __forceinline__ float gelu_tanh(float x) {
    const float u = 0.7978845608028654f * (x + 0.044715f * x * x * x);
    const float e = __expf(2.f * u);
    const float th = 1.f - 2.f / (e + 1.f);
    return 0.5f * x * (1.f + th);
}
__device__ __forceinline__ void cmp2_phase(Frame& F, int lo, int hi) {
    int tid_ = F.tid; asm volatile("" : "+v"(tid_));
    const int lane = tid_ & 63, idx = lane & 15, q = lane >> 4, w = F.wave;
    const float* cb = (const float*)(F.ws + WS_CBIAS);
    for (int unit = lo + F.vcu; unit < hi; unit += F.G) {
        const bool smp = unit < 512; const int uu = smp ? unit : unit - 512; const int sg = uu >> 1, kind = uu & 1;
        const int i = 16 * w + idx;
        bf16x8 gf[4];
        if (smp) {
            const bf16* TB = (const bf16*)(F.ws + WS_TBS) + ((size_t)kind * 32768 + (size_t)sg * 128) * 256;
#pragma unroll
            for (int ks = 0; ks < 4; ++ks) { const int k = 32 * ks + 8 * q;
                v4u tv = {0u, 0u, 0u, 0u}, bv = {0u, 0u, 0u, 0u};
                if (i < NCMP) { tv = *(const v4u*)(TB + (size_t)i * 256 + k); bv = *(const v4u*)(TB + (size_t)(i + 1) * 256 + 128 + k); }
                const f32x4 c0 = *(const f32x4*)(cb + kind * 128 + k), c1 = *(const f32x4*)(cb + kind * 128 + k + 4);
                float h[8];
                h[0] = bf_lo(tv.x) + bf_lo(bv.x) + c0[0]; h[1] = bf_hi(tv.x) + bf_hi(bv.x) + c0[1]; h[2] = bf_lo(tv.y) + bf_lo(bv.y) + c0[2]; h[3] = bf_hi(tv.y) + bf_hi(bv.y) + c0[3];
                h[4] = bf_lo(tv.z) + bf_lo(bv.z) + c1[0]; h[5] = bf_hi(tv.z) + bf_hi(bv.z) + c1[1]; h[6] = bf_lo(tv.w) + bf_lo(bv.w) + c1[2]; h[7] = bf_hi(tv.w) + bf_hi(bv.w) + c1[3];
#pragma unroll
                for (int e = 0; e < 8; ++e) h[e] = (i < NCMP) ? gelu_tanh(h[e]) : 0.f;
                v4u o; o.x = cvtpk(h[0], h[1]); o.y = cvtpk(h[2], h[3]); o.z = cvtpk(h[4], h[5]); o.w = cvtpk(h[6], h[7]);
                gf[ks] = __builtin_bit_cast(bf16x8, o); }
        } else {
            const float* TB = (const float*)(F.ws + WS_TBP) + ((size_t)kind * 1024 + (size_t)sg * 128) * 256;
#pragma unroll
            for (int ks = 0; ks < 4; ++ks) { const int k = 32 * ks + 8 * q;
                f32x4 t0 = {0.f, 0.f, 0.f, 0.f}, t1 = t0, b0 = t0, b1 = t0;
                if (i < NCMP) {
#pragma unroll
                    for (int sl = 0; sl < 8; ++sl) { const float* T8 = TB + (size_t)sl * (2048 * 256);
                        t0 = t0 + *(const f32x4*)(T8 + (size_t)i * 256 + k); t1 = t1 + *(const f32x4*)(T8 + (size_t)i * 256 + k + 4);
                        b0 = b0 + *(const f32x4*)(T8 + (size_t)(i + 1) * 256 + 128 + k); b1 = b1 + *(const f32x4*)(T8 + (size_t)(i + 1) * 256 + 128 + k + 4); } }
                const f32x4 c0 = *(const f32x4*)(cb + kind * 128 + k), c1 = *(const f32x4*)(cb + kind * 128 + k + 4);
                float h[8];
#pragma unroll
                for (int e = 0; e < 4; ++e) { h[e] = t0[e] + b0[e] + c0[e]; h[4 + e] = t1[e] + b1[e] + c1[e]; }
#pragma unroll
                for (int e = 0; e < 8; ++e) h[e] = (i < NCMP) ? gelu_tanh(h[e]) : 0.f;
                v4u o; o.x = cvtpk(h[0], h[1]); o.y = cvtpk(h[2], h[3]); o.z = cvtpk(h[4], h[5]); o.w = cvtpk(h[6], h[7]);
                gf[ks] = __builtin_bit_cast(bf16x8, o); }
        }
        const bf16* W2 = (const bf16*)(F.ws + WS_WC2_T) + (size_t)kind * 128 * 128;
        const bool transposed = (!smp) && kind == 1;
        bf16* outp = smp ? (bf16*)(F.ws + WS_CMPS) + ((size_t)sg * 2 + kind) * 16384 : (bf16*)(F.ws + WS_CMPP) + ((size_t)sg * 2 + kind) * 16384;
#pragma unroll 2
        for (int nt = 0; nt < 8; ++nt) {
            f32x4 acc = {0.f, 0.f, 0.f, 0.f};
            if (!transposed) {
#pragma unroll
                for (int ks = 0; ks < 4; ++ks) { const bf16x8 wf = *(const bf16x8*)(W2 + (size_t)(16 * nt + idx) * 128 + 32 * ks + 8 * q); acc = mfma16(wf, gf[ks], acc); }
                u32x2v o; o.x = cvtpk(acc[0], acc[1]); o.y = cvtpk(acc[2], acc[3]);
                *(u32x2v*)(outp + (size_t)i * 128 + 16 * nt + 4 * q) = o;
            } else {
#pragma unroll
                for (int ks = 0; ks < 4; ++ks) { const bf16x8 wf = *(const bf16x8*)(W2 + (size_t)(16 * nt + idx) * 128 + 32 * ks + 8 * q); acc = mfma16(gf[ks], wf, acc); }
                u32x2v o; o.x = cvtpk(acc[0], acc[1]); o.y = cvtpk(acc[2], acc[3]);
                *(u32x2v*)(outp + (size_t)(16 * nt + idx) * 128 + 16 * w + 4 * q) = o;
            }
        }
    }
}

__device__ __forceinline__ void p5_rows(Frame& F, const Args& A) {
    const int gw = F.vcu * NWAVES + F.wave, NGW = F.G * NWAVES;
    const float* Mb = (const float*)(F.ws + WS_M); const float* ss1 = (const float*)(F.ws + WS_SSP); const float* gpost = A.in[17];
    for (int m = gw; m < MTOK; m += NGW) {
        const float* xrow = (m < NPTOK) ? A.in[0] + (size_t)m * DM : A.in[1] + (size_t)(m - NPTOK) * DM;
        float* orow = F.out + ((m < NPTOK) ? O_YP + (size_t)m * DM : O_YS + (size_t)(m - NPTOK) * DM);
        const f32x4* xr = (const f32x4*)xrow + F.lane; const f32x4* mr = (const f32x4*)(Mb + (size_t)m * DM) + F.lane; const f32x4* gr = (const f32x4*)gpost + F.lane;
        const float r1 = 1.f / sqrtf(wave_sum(F.lane < 32 ? ss1[(size_t)m * 32 + F.lane] : 0.f) * (1.f / DM) + EPS);
        f32x4 v[8]; float s = 0.f;
#pragma unroll
        for (int j = 0; j < 8; ++j) { v[j] = xr[64 * j] + mr[64 * j] * gr[64 * j] * r1; s += (v[j].x * v[j].x + v[j].y * v[j].y) + (v[j].z * v[j].z + v[j].w * v[j].w); }
        const float r2 = 1.f / sqrtf(wave_sum(s) * (1.f / DM) + EPS);
        f32x4* o4 = (f32x4*)orow + F.lane;
        u32x2v* o8 = (u32x2v*)((bf16*)(F.ws + WS_XN) + (size_t)m * DM) + F.lane;
#pragma unroll
        for (int j = 0; j < 8; ++j) { o4[64 * j] = v[j]; u32x2v w; w.x = cvtpk(v[j].x * r2, v[j].y * r2); w.y = cvtpk(v[j].z * r2, v[j].w * r2); o8[64 * j] = w; }
    }
}
__device__ __forceinline__ void p8_rows(Frame& F, const Args& A) {
    const int gw = F.vcu * NWAVES + F.wave, NGW = F.G * NWAVES;
    const float* Mb = (const float*)(F.ws + WS_M); const float* ss2 = (const float*)(F.ws + WS_SSP) + (size_t)MROWS * 32; const float* gpost = A.in[21];
    for (int m = gw; m < MTOK; m += NGW) {
        float* orow = F.out + ((m < NPTOK) ? O_YP + (size_t)m * DM : O_YS + (size_t)(m - NPTOK) * DM);
        f32x4* o4 = (f32x4*)orow + F.lane; const f32x4* mr = (const f32x4*)(Mb + (size_t)m * DM) + F.lane; const f32x4* gr = (const f32x4*)gpost + F.lane;
        const float r = 1.f / sqrtf(wave_sum(F.lane < 32 ? ss2[(size_t)m * 32 + F.lane] : 0.f) * (1.f / DM) + EPS);
#pragma unroll
        for (int j = 0; j < 8; ++j) o4[64 * j] = o4[64 * j] + mr[64 * j] * gr[64 * j] * r;
    }
}

constexpr int AT_KROW = 272, AT_VROW = 144;
constexpr int AT_KBUF = 64 * AT_KROW, AT_VBUF = 128 * AT_VROW;
constexpr int AT_K0 = 0, AT_K1 = AT_KBUF, AT_V0 = 2 * AT_KBUF, AT_V1 = AT_V0 + AT_VBUF, AT_SC = AT_V1 + AT_VBUF, AT_END = AT_SC + 8192;
static_assert(AT_END <= RING_BYTES, "attention LDS");

struct TileRegs { v4u k[2], v[2]; };
__device__ __forceinline__ void tile_load(TileRegs& R, const bf16* ksrc  , const bf16* vsrc  , int vpitch, int tid) {
#pragma unroll
    for (int j = 0; j < 2; ++j) { const int c = tid + 512 * j;
        R.k[j] = *(const v4u*)(ksrc + (size_t)(c >> 4) * 128 + (c & 15) * 8);
        R.v[j] = *(const v4u*)(vsrc + (size_t)(c >> 3) * vpitch + (c & 7) * 8); }
}
__device__ __forceinline__ void tile_store(const TileRegs& R, LAS unsigned char* kb, LAS unsigned char* vb, int tid) {
#pragma unroll
    for (int j = 0; j < 2; ++j) { const int c = tid + 512 * j;
        *(LAS v4u*)(kb + (c >> 4) * AT_KROW + (c & 15) * 16) = R.k[j];
        *(LAS v4u*)(vb + (c >> 3) * AT_VROW + (c & 7) * 16) = R.v[j]; }
}
__device__ __forceinline__ void qk_tile(f32x4 (&s)[4][2], const LAS unsigned char* kb, const bf16x8 (&qf)[2][4], int idx, int q) {
#pragma unroll
    for (int kt = 0; kt < 4; ++kt) { s[kt][0] = (f32x4){0.f, 0.f, 0.f, 0.f}; s[kt][1] = (f32x4){0.f, 0.f, 0.f, 0.f}; }
    const LAS unsigned char* kp = kb + idx * AT_KROW + q * 16;
#pragma unroll
    for (int ks = 0; ks < 4; ++ks) {
#pragma unroll
        for (int kt = 0; kt < 4; ++kt) { const bf16x8 kf = *(const LAS bf16x8*)(kp + kt * 16 * AT_KROW + ks * 64);
            s[kt][0] = mfma16(kf, qf[0][ks], s[kt][0]); s[kt][1] = mfma16(kf, qf[1][ks], s[kt][1]); }
        __builtin_amdgcn_sched_barrier(0);
    }
}
__device__ __forceinline__ void pv_tile(f32x4 (&o)[8][2], const LAS unsigned char* vb, const f32x4 (&p)[4][2], int idx, int q) {
    bf16x8 pf[2][2];
#pragma unroll
    for (int rt = 0; rt < 2; ++rt)
#pragma unroll
        for (int jj = 0; jj < 2; ++jj) { v4u w; w.x = cvtpk(p[2 * jj][rt][0], p[2 * jj][rt][1]); w.y = cvtpk(p[2 * jj][rt][2], p[2 * jj][rt][3]);
            w.z = cvtpk(p[2 * jj + 1][rt][0], p[2 * jj + 1][rt][1]); w.w = cvtpk(p[2 * jj + 1][rt][2], p[2 * jj + 1][rt][3]); pf[rt][jj] = __builtin_bit_cast(bf16x8, w); }
    const LAS unsigned char* vp = vb + idx * AT_VROW + q * 8;
#pragma unroll
    for (int dt = 0; dt < 8; ++dt) {
#pragma unroll
        for (int jj = 0; jj < 2; ++jj) { const u32x2v lo = *(const LAS u32x2v*)(vp + dt * 16 * AT_VROW + jj * 64), hi = *(const LAS u32x2v*)(vp + dt * 16 * AT_VROW + jj * 64 + 32);
            v4u w; w.x = lo.x; w.y = lo.y; w.z = hi.x; w.w = hi.y; const bf16x8 vf = __builtin_bit_cast(bf16x8, w);
            o[dt][0] = mfma16(vf, pf[0][jj], o[dt][0]); o[dt][1] = mfma16(vf, pf[1][jj], o[dt][1]); }
        if (dt & 1) __builtin_amdgcn_sched_barrier(0);
    }
}
__device__ __forceinline__ void osm_update(f32x4 (&s)[4][2], f32x4 (&o)[8][2], float (&mrow)[2], float (&lrow)[2]) {
#pragma unroll
    for (int rt = 0; rt < 2; ++rt) {
        float tmax = s[0][rt][0];
#pragma unroll
        for (int kt = 0; kt < 4; ++kt)
#pragma unroll
            for (int i = 0; i < 4; ++i) tmax = fmaxf(tmax, s[kt][rt][i]);
        tmax = fmaxf(tmax, __shfl_xor(tmax, 16)); tmax = fmaxf(tmax, __shfl_xor(tmax, 32));
        const float mnew = fmaxf(mrow[rt], tmax);
        const float alpha = __builtin_amdgcn_exp2f(mrow[rt] - mnew);
        mrow[rt] = mnew;
        float ps = 0.f;
#pragma unroll
        for (int kt = 0; kt < 4; ++kt)
#pragma unroll
            for (int i = 0; i < 4; ++i) { const float p = __builtin_amdgcn_exp2f(s[kt][rt][i] - mnew); s[kt][rt][i] = p; ps += p; }
        lrow[rt] = lrow[rt] * alpha + ps;
#pragma unroll
        for (int dt = 0; dt < 8; ++dt) o[dt][rt] = o[dt][rt] * alpha;
    }
}

__device__ __forceinline__ void attn_prompt_unit(Frame& F, int b, int g, int ti) {
    int tid_ = F.tid; asm volatile("" : "+v"(tid_));
    const int tid = tid_, lane = tid & 63, w = F.wave, idx = lane & 15, q = lane >> 4, head = idx & 3;
    LAS unsigned char* L = F.lds + RING_OFF;
    const float NEG = -__builtin_inff();
    const int t0 = ti * 64, bg = b * NG + g;
    const bf16* Qb = (const bf16*)(F.ws + WS_Q);
    const bf16* KSb = (const bf16*)(F.ws + WS_KS) + (size_t)bg * SEQ * 128;   const bf16* VSb = (const bf16*)(F.ws + WS_VST) + (size_t)bg * 128 * SEQ;
    const bf16* KWb = (const bf16*)(F.ws + WS_KW) + (size_t)bg * SEQ * 128;   const bf16* VWb = (const bf16*)(F.ws + WS_VWT) + (size_t)bg * 128 * SEQ;
    const bf16* KCb = (const bf16*)(F.ws + WS_CMPP) + (size_t)(bg * 2 + 0) * 16384; const bf16* VCb = (const bf16*)(F.ws + WS_CMPP) + (size_t)(bg * 2 + 1) * 16384;
    int qpos[2]; bf16x8 qf[2][4]; float gate[2][3];
#pragma unroll
    for (int rt = 0; rt < 2; ++rt) { qpos[rt] = t0 + 8 * w + 4 * rt + (idx >> 2);
        const size_t grow = (size_t)b * SEQ + qpos[rt];
        const bf16* qp = Qb + grow * 1024 + (4 * g + head) * 128 + 8 * q;
#pragma unroll
        for (int ks = 0; ks < 4; ++ks) qf[rt][ks] = *(const bf16x8*)(qp + 32 * ks);
        const float* gp = (const float*)(F.ws + WS_GATES) + grow * 24 + (4 * g + head) * 3;
        gate[rt][0] = gp[0]; gate[rt][1] = gp[1]; gate[rt][2] = gp[2]; }
    bf16* const CC = (bf16*)(F.ws + WS_CONCAT);
    unsigned selmask[2];
    TileRegs R;
    {
        tile_load(R, KCb, VCb, 128, tid); tile_store(R, L + AT_K0, L + AT_V0, tid);
        tile_load(R, KCb + 64 * 128, VCb + 64, 128, tid); tile_store(R, L + AT_K1, L + AT_V1, tid);
        __syncthreads();
        f32x4 s0[4][2], s1[4][2];
        qk_tile(s0, L + AT_K0, qf, idx, q); qk_tile(s1, L + AT_K1, qf, idx, q);
        float inv[2];
#pragma unroll
        for (int rt = 0; rt < 2; ++rt) {
            const int nmax = (qpos[rt] - 31) >> 4;
            float tmax = NEG;
#pragma unroll
            for (int kt = 0; kt < 4; ++kt)
#pragma unroll
                for (int i = 0; i < 4; ++i) { const int n0 = 16 * kt + 4 * q + i, n1 = n0 + 64;
                    const float a = (n0 <= nmax) ? s0[kt][rt][i] * SM_C2 : NEG, c = (n1 <= nmax && n1 < NCMP) ? s1[kt][rt][i] * SM_C2 : NEG;
                    s0[kt][rt][i] = a; s1[kt][rt][i] = c; tmax = fmaxf(tmax, fmaxf(a, c)); }
            tmax = fmaxf(tmax, __shfl_xor(tmax, 16)); tmax = fmaxf(tmax, __shfl_xor(tmax, 32));
            const float mx = fmaxf(tmax, -1e30f);
            float ps = 0.f;
#pragma unroll
            for (int kt = 0; kt < 4; ++kt)
#pragma unroll
                for (int i = 0; i < 4; ++i) { const float a = __builtin_amdgcn_exp2f(s0[kt][rt][i] - mx), c = __builtin_amdgcn_exp2f(s1[kt][rt][i] - mx); s0[kt][rt][i] = a; s1[kt][rt][i] = c; ps += a + c; }
            ps += __shfl_xor(ps, 16); ps += __shfl_xor(ps, 32);
            inv[rt] = ps > 0.f ? 1.f / ps : 1.f;
#pragma unroll
            for (int kt = 0; kt < 4; ++kt) { s0[kt][rt] = s0[kt][rt] * inv[rt]; s1[kt][rt] = s1[kt][rt] * inv[rt]; }
        }
        float G8[2][8], L8[2][8];
#pragma unroll
        for (int rt = 0; rt < 2; ++rt)
#pragma unroll
            for (int kt = 0; kt < 4; ++kt) { G8[rt][kt] = (s0[kt][rt][0] + s0[kt][rt][1]) + (s0[kt][rt][2] + s0[kt][rt][3]); L8[rt][kt] = s0[kt][rt][3];
                                             G8[rt][4 + kt] = (s1[kt][rt][0] + s1[kt][rt][1]) + (s1[kt][rt][2] + s1[kt][rt][3]); L8[rt][4 + kt] = s1[kt][rt][3]; }
        {
            f32x4 o[8][2];
#pragma unroll
            for (int dt = 0; dt < 8; ++dt) { o[dt][0] = (f32x4){0.f, 0.f, 0.f, 0.f}; o[dt][1] = (f32x4){0.f, 0.f, 0.f, 0.f}; }
            pv_tile(o, L + AT_V0, s0, idx, q); pv_tile(o, L + AT_V1, s1, idx, q);
#pragma unroll
            for (int dt = 0; dt < 8; ++dt)
#pragma unroll
                for (int rt = 0; rt < 2; ++rt) { const f32x4 v = o[dt][rt] * gate[rt][0]; u32x2v pk; pk.x = cvtpk(v[0], v[1]); pk.y = cvtpk(v[2], v[3]);
                    *(u32x2v*)(CC + ((size_t)b * SEQ + qpos[rt]) * DM + (4 * g + head) * 128 + 4 * q + 16 * dt) = pk; }
        }
        __builtin_amdgcn_sched_barrier(0);
        LAS float* SC = (LAS float*)(L + AT_SC);
#pragma unroll
        for (int rt = 0; rt < 2; ++rt) {
            float T8[8];
#pragma unroll
            for (int k8 = 0; k8 < 8; ++k8) T8[k8] = __shfl(L8[rt][k8], (lane + 48) & 63);
            const int jt = ti;
#pragma unroll
            for (int k8 = 0; k8 < 8; ++k8) {
                const float prev = (k8 > 0) ? T8[k8 > 0 ? k8 - 1 : 0] : 0.f;
                float im = G8[rt][k8] + (q == 0 ? prev : T8[k8]);
                im += __shfl_xor(im, 1); im += __shfl_xor(im, 2);
                const int sb = 4 * k8 + q;
                const bool force = (sb == 0) | (sb == jt) | (sb == jt - 1);
                const float score = force ? 1e4f : ((sb <= jt) ? im : -1.f);
                SC[(w * 8 + 4 * rt + (idx >> 2)) * 32 + sb] = score;
            }
            __builtin_amdgcn_sched_barrier(0);
        }
        LDS_WAIT(); asm volatile("" ::: "memory");
#pragma unroll
        for (int rt = 0; rt < 2; ++rt) {
            const LAS f32x4* sp = (const LAS f32x4*)(SC + (w * 8 + 4 * rt + (idx >> 2)) * 32);
            float sc[32];
#pragma unroll
            for (int k = 0; k < 8; ++k) { const f32x4 v = sp[k]; sc[4 * k] = v[0]; sc[4 * k + 1] = v[1]; sc[4 * k + 2] = v[2]; sc[4 * k + 3] = v[3]; }
            unsigned mk = 0u;
#pragma unroll
            for (int k8 = 0; k8 < 8; ++k8) {
                const float mine = (q == 0) ? sc[4 * k8] : (q == 1) ? sc[4 * k8 + 1] : (q == 2) ? sc[4 * k8 + 2] : sc[4 * k8 + 3];
                const int sb = 4 * k8 + q;
                int rank = 0;
#pragma unroll
                for (int o2 = 0; o2 < 32; ++o2) rank += ((sc[o2] > mine) | ((sc[o2] == mine) & (o2 < sb))) ? 1 : 0;
                mk |= (rank < TOPK) ? (1u << sb) : 0u;
            }
            mk |= __shfl_xor(mk, 16); mk |= __shfl_xor(mk, 32);
            selmask[rt] = mk;
            __builtin_amdgcn_sched_barrier(0);
        }
        __syncthreads();
    }
#ifndef PROBE_MODE_LO
#define PROBE_MODE_LO 0
#define PROBE_MODE_HI 2
#endif
#pragma unroll 1
    for (int mode = PROBE_MODE_LO; mode < PROBE_MODE_HI; ++mode) {
        const bf16* Kb = mode ? KWb : KSb; const bf16* Vb = mode ? VWb : VSb;
        const int jlo = mode ? ((ti > 8) ? ti - 8 : 0) : 0, jhi = ti;
        f32x4 o[8][2]; float mrow[2] = {-1e30f, -1e30f}, lrow[2] = {0.f, 0.f};
#pragma unroll
        for (int dt = 0; dt < 8; ++dt) { o[dt][0] = (f32x4){0.f, 0.f, 0.f, 0.f}; o[dt][1] = (f32x4){0.f, 0.f, 0.f, 0.f}; }
        tile_load(R, Kb + (size_t)jlo * 64 * 128, Vb + jlo * 64, SEQ, tid); tile_store(R, L + AT_K0, L + AT_V0, tid);
        __syncthreads();
#pragma unroll 1
        for (int j = jlo; j <= jhi; ++j) {
            const int par = (j - jlo) & 1;
            LAS unsigned char* kb = L + (par ? AT_K1 : AT_K0); LAS unsigned char* vb = L + (par ? AT_V1 : AT_V0);
            if (j < jhi) tile_load(R, Kb + (size_t)(j + 1) * 64 * 128, Vb + (j + 1) * 64, SEQ, tid);
            f32x4 s[4][2];
            qk_tile(s, kb, qf, idx, q);
            const int key0 = 64 * j;
#pragma unroll
            for (int rt = 0; rt < 2; ++rt) {
                const bool rowok = mode ? true : (((selmask[rt] >> j) & 1u) != 0u);
                const int lo = mode ? qpos[rt] - (WB - 1) : 0;
#pragma unroll
                for (int kt = 0; kt < 4; ++kt)
#pragma unroll
                    for (int i = 0; i < 4; ++i) { const int key = key0 + 16 * kt + 4 * q + i;
                        const bool ok = rowok && key <= qpos[rt] && key >= lo;
                        s[kt][rt][i] = ok ? s[kt][rt][i] * SM_C2 : NEG; }
            }
            osm_update(s, o, mrow, lrow);
            pv_tile(o, vb, s, idx, q);
            if (j < jhi) tile_store(R, L + (par ? AT_K0 : AT_K1), L + (par ? AT_V0 : AT_V1), tid);
            __syncthreads();
        }
#pragma unroll
        for (int rt = 0; rt < 2; ++rt) { float l = lrow[rt]; l += __shfl_xor(l, 16); l += __shfl_xor(l, 32);
            const float sc = (mode ? gate[rt][2] : gate[rt][1]) * (l > 0.f ? 1.f / l : 1.f);
#pragma unroll
            for (int dt = 0; dt < 8; ++dt) { const f32x4 v = o[dt][rt] * sc;
                u32x2v* op = (u32x2v*)(CC + ((size_t)b * SEQ + qpos[rt]) * DM + (4 * g + head) * 128 + 4 * q + 16 * dt);
                u32x2v pk = *op; pk.x = cvtpk(bf_lo(pk.x) + v[0], bf_hi(pk.x) + v[1]); pk.y = cvtpk(bf_lo(pk.y) + v[2], bf_hi(pk.y) + v[3]); *op = pk; } }
    }
}

constexpr int SA_SCC = 0;
constexpr int SA_SSEL = 2048;
constexpr int SA_SWIN = SA_SSEL + 4 * 964 * 4;
constexpr int SA_RED = SA_SWIN + 4 * 512 * 4;
constexpr int SA_MISC = SA_RED + 8 * 4 * 128 * 4;
constexpr int SA_END = SA_MISC + 1024;
static_assert(SA_END <= RING_BYTES, "sample attention LDS");
constexpr int NSELROWS = 15 * 64 + 1;

__device__ __forceinline__ void dot4(float (&sc)[4], const float (&qv)[4][8], const f32x4 a, const f32x4 b) {
#pragma unroll
    for (int h = 0; h < 4; ++h) { float t = qv[h][0] * a[0]; t = fmaf(qv[h][1], a[1], t); t = fmaf(qv[h][2], a[2], t); t = fmaf(qv[h][3], a[3], t);
        t = fmaf(qv[h][4], b[0], t); t = fmaf(qv[h][5], b[1], t); t = fmaf(qv[h][6], b[2], t); t = fmaf(qv[h][7], b[3], t);
        t += __shfl_xor(t, 1); t += __shfl_xor(t, 2); t += __shfl_xor(t, 4); t += __shfl_xor(t, 8); sc[h] = t * SM_C2; }
}
__device__ __forceinline__ void axpy4(float (&acc)[4][8], const float (&p)[4], const f32x4 a, const f32x4 b) {
#pragma unroll
    for (int h = 0; h < 4; ++h) {
#pragma unroll
        for (int e = 0; e < 4; ++e) { acc[h][e] = fmaf(p[h], a[e], acc[h][e]); acc[h][4 + e] = fmaf(p[h], b[e], acc[h][4 + e]); } }
}

__device__ __forceinline__ void attn_sample_unit(Frame& F, const Args& A, int s, int g) {
    int tid_ = F.tid; asm volatile("" : "+v"(tid_));
    const int tid = tid_, lane = tid & 63, w = F.wave, r = lane >> 4, c = lane & 15;
    LAS unsigned char* L = F.lds + RING_OFF;
    LAS float* SCC = (LAS float*)(L + SA_SCC); LAS float* SSEL = (LAS float*)(L + SA_SSEL); LAS float* SWIN = (LAS float*)(L + SA_SWIN);
    LAS float* RED = (LAS float*)(L + SA_RED); LAS int* BLKROW = (LAS int*)(L + SA_MISC); LAS float* COEF = (LAS float*)(L + SA_MISC + 64); LAS float* SCORE = (LAS float*)(L + SA_MISC + 128);
    const int sg = s * 2 + g;
    const float* cache = A.in[2]; const float* swin = A.in[3]; const int* pt = (const int*)A.in[5];
    const bf16* KC = (const bf16*)(F.ws + WS_CMPS) + (size_t)(sg * 2 + 0) * 16384; const bf16* VC = (const bf16*)(F.ws + WS_CMPS) + (size_t)(sg * 2 + 1) * 16384;
    const float* gates = (const float*)(F.ws + WS_GATES) + (size_t)(NPTOK + s) * 24 + 4 * g * 3;
    float* wout = F.out + O_WINS + (size_t)s * WB * 512;
    const float* knew_sel = F.out + O_KVS + (size_t)s * 1024 + 512 + g * 128;
    float qv[4][8];
    { const bf16* qp = (const bf16*)(F.ws + WS_Q) + (size_t)(NPTOK + s) * 1024 + 4 * g * 128 + 8 * c;
#pragma unroll
      for (int h = 0; h < 4; ++h) { const v4u t = *(const v4u*)(qp + h * 128);
          qv[h][0] = bf_lo(t.x); qv[h][1] = bf_hi(t.x); qv[h][2] = bf_lo(t.y); qv[h][3] = bf_hi(t.y); qv[h][4] = bf_lo(t.z); qv[h][5] = bf_hi(t.z); qv[h][6] = bf_lo(t.w); qv[h][7] = bf_hi(t.w); } }
    for (int grp = w; grp < 32; grp += 8) { const int n = 4 * grp + r;
        const v4u t = *(const v4u*)(KC + (size_t)n * 128 + 8 * c);
        const f32x4 a = {bf_lo(t.x), bf_hi(t.x), bf_lo(t.y), bf_hi(t.y)}, b = {bf_lo(t.z), bf_hi(t.z), bf_lo(t.w), bf_hi(t.w)};
        float sc[4]; dot4(sc, qv, a, b);
        if (c == 0) {
#pragma unroll
            for (int h = 0; h < 4; ++h) SCC[h * 128 + n] = sc[h]; } }
    __syncthreads();
    if (w < 4) { const int h = w;
        const float a = SCC[h * 128 + lane], b = (lane + 64 < NCMP) ? SCC[h * 128 + 64 + lane] : -__builtin_inff();
        float mx = fmaxf(a, b);
#pragma unroll
        for (int o = 1; o < 64; o <<= 1) mx = fmaxf(mx, __shfl_xor(mx, o));
        const float ea = __builtin_amdgcn_exp2f(a - mx), eb = __builtin_amdgcn_exp2f(b - mx);
        const float inv = 1.f / wave_sum(ea + eb);
        SCC[h * 128 + lane] = ea * inv; SCC[h * 128 + 64 + lane] = eb * inv; }
    __syncthreads();
    if (w == 0) {
        const int sb = lane;
        float im = 0.f;
        if (sb < NSEL_S) {
#pragma unroll
            for (int k = -1; k < 4; ++k) { const int n = 4 * sb + k; if (n >= 0 && n < NCMP) im += (SCC[n] + SCC[128 + n]) + (SCC[256 + n] + SCC[384 + n]); } }
        const bool force = (sb == 0) || (sb == 32) || (sb == 31);
        const float score = (sb < NSEL_S) ? (force ? 1e4f : im) : -2.f;
        SCORE[lane] = score;
        LDS_WAIT(); asm volatile("" ::: "memory");
        int rank = 0;
        for (int o = 0; o < NSEL_S; ++o) { const float v = SCORE[o]; rank += (v > score || (v == score && o < sb)) ? 1 : 0; }
        const bool sel = (sb < 32) && (rank < TOPK);
        const unsigned long long bm = __ballot(sel);
        const int posn = __popcll(bm & ((1ull << sb) - 1ull));
        if (sel && posn < 15) BLKROW[posn] = pt[s * NPAGES + (sb >> 1)] * PAGE + (sb & 1) * 64;
        if (lane < 12) { const int h = lane / 3, br = lane % 3; if (br == 0) COEF[h] = gates[h * 3]; }
    }
    __syncthreads();
    for (int grp0 = w; grp0 < 241; grp0 += 32) {
        f32x4 a[4], b[4]; int rho[4];
#pragma unroll
        for (int u = 0; u < 4; ++u) { const int grp = grp0 + 8 * u; rho[u] = 4 * grp + r;
            const float* src = knew_sel + 8 * c;
            if (rho[u] < 960) src = cache + ((size_t)(BLKROW[rho[u] >> 6] + (rho[u] & 63))) * 1024 + 512 + g * 128 + 8 * c;
            if (grp < 241 && rho[u] < NSELROWS) { a[u] = *(const f32x4*)src; b[u] = *(const f32x4*)(src + 4); } else { a[u] = (f32x4){0.f, 0.f, 0.f, 0.f}; b[u] = a[u]; } }
#pragma unroll
        for (int u = 0; u < 4; ++u) { float sc[4]; dot4(sc, qv, a[u], b[u]);
            if (c == 0 && rho[u] < NSELROWS && grp0 + 8 * u < 241) {
#pragma unroll
                for (int h = 0; h < 4; ++h) SSEL[h * 964 + rho[u]] = sc[h]; } }
    }
    for (int grp0 = w; grp0 < 128; grp0 += 32) {
        f32x4 a[4], b[4]; int rho[4];
#pragma unroll
        for (int u = 0; u < 4; ++u) { const int grp = grp0 + 8 * u; rho[u] = 4 * grp + r;
            const float* src = (rho[u] < 511) ? swin + ((size_t)(s * WB + rho[u] + 1) * 2 + 0) * 256 + g * 128 + 8 * c : wout + ((size_t)511 * 2 + 0) * 256 + g * 128 + 8 * c;
            a[u] = *(const f32x4*)src; b[u] = *(const f32x4*)(src + 4);
            if (rho[u] < 511) { float* dst = wout + ((size_t)rho[u] * 2 + 0) * 256 + g * 128 + 8 * c; *(f32x4*)dst = a[u]; *(f32x4*)(dst + 4) = b[u]; } }
#pragma unroll
        for (int u = 0; u < 4; ++u) { float sc[4]; dot4(sc, qv, a[u], b[u]);
            if (c == 0) {
#pragma unroll
                for (int h = 0; h < 4; ++h) SWIN[h * 512 + rho[u]] = sc[h]; } }
    }
    __syncthreads();
    { const int br = w >> 2, h = w & 3, n = br ? 512 : NSELROWS; LAS float* P = br ? SWIN + h * 512 : SSEL + h * 964;
      float mx = -__builtin_inff();
      for (int i = lane; i < n; i += 64) mx = fmaxf(mx, P[i]);
#pragma unroll
      for (int o = 1; o < 64; o <<= 1) mx = fmaxf(mx, __shfl_xor(mx, o));
      float sum = 0.f;
      for (int i = lane; i < n; i += 64) { const float e = __builtin_amdgcn_exp2f(P[i] - mx); P[i] = e; sum += e; }
      sum = wave_sum(sum);
      if (lane == 0) COEF[(1 + br) * 4 + h] = gates[h * 3 + 1 + br] / sum; }
    __syncthreads();
    float acc[4][8];
#pragma unroll
    for (int h = 0; h < 4; ++h)
#pragma unroll
        for (int e = 0; e < 8; ++e) acc[h][e] = 0.f;
    { float cf[4];
#pragma unroll
      for (int h = 0; h < 4; ++h) cf[h] = COEF[h];
      for (int grp = w; grp < 32; grp += 8) { const int n = 4 * grp + r;
          const v4u t = *(const v4u*)(VC + (size_t)n * 128 + 8 * c);
          const f32x4 a = {bf_lo(t.x), bf_hi(t.x), bf_lo(t.y), bf_hi(t.y)}, b = {bf_lo(t.z), bf_hi(t.z), bf_lo(t.w), bf_hi(t.w)};
          float p[4];
#pragma unroll
          for (int h = 0; h < 4; ++h) p[h] = SCC[h * 128 + n] * cf[h];
          axpy4(acc, p, a, b); } }
    { float cf[4];
#pragma unroll
      for (int h = 0; h < 4; ++h) cf[h] = COEF[4 + h];
      for (int grp0 = w; grp0 < 241; grp0 += 32) {
          f32x4 a[4], b[4]; int rho[4];
#pragma unroll
          for (int u = 0; u < 4; ++u) { const int grp = grp0 + 8 * u; rho[u] = 4 * grp + r;
              const float* src = knew_sel + 256 + 8 * c;
              if (rho[u] < 960) src = cache + ((size_t)(BLKROW[rho[u] >> 6] + (rho[u] & 63))) * 1024 + 768 + g * 128 + 8 * c;
              if (grp < 241 && rho[u] < NSELROWS) { a[u] = *(const f32x4*)src; b[u] = *(const f32x4*)(src + 4); } else { a[u] = (f32x4){0.f, 0.f, 0.f, 0.f}; b[u] = a[u]; } }
#pragma unroll
          for (int u = 0; u < 4; ++u) { float p[4]; const bool ok = rho[u] < NSELROWS && grp0 + 8 * u < 241;
#pragma unroll
              for (int h = 0; h < 4; ++h) p[h] = ok ? SSEL[h * 964 + rho[u]] * cf[h] : 0.f;
              axpy4(acc, p, a[u], b[u]); } } }
    { float cf[4];
#pragma unroll
      for (int h = 0; h < 4; ++h) cf[h] = COEF[8 + h];
      for (int grp0 = w; grp0 < 128; grp0 += 32) {
          f32x4 a[4], b[4]; int rho[4];
#pragma unroll
          for (int u = 0; u < 4; ++u) { const int grp = grp0 + 8 * u; rho[u] = 4 * grp + r;
              const float* src = (rho[u] < 511) ? swin + ((size_t)(s * WB + rho[u] + 1) * 2 + 1) * 256 + g * 128 + 8 * c : wout + ((size_t)511 * 2 + 1) * 256 + g * 128 + 8 * c;
              a[u] = *(const f32x4*)src; b[u] = *(const f32x4*)(src + 4);
              if (rho[u] < 511) { float* dst = wout + ((size_t)rho[u] * 2 + 1) * 256 + g * 128 + 8 * c; *(f32x4*)dst = a[u]; *(f32x4*)(dst + 4) = b[u]; } }
#pragma unroll
          for (int u = 0; u < 4; ++u) { float p[4];
#pragma unroll
              for (int h = 0; h < 4; ++h) p[h] = SWIN[h * 512 + rho[u]] * cf[h];
              axpy4(acc, p, a[u], b[u]); } } }
#pragma unroll
    for (int h = 0; h < 4; ++h)
#pragma unroll
        for (int e = 0; e < 8; ++e) { float v = acc[h][e]; v += __shfl_xor(v, 16); v += __shfl_xor(v, 32); acc[h][e] = v; }
    if (r == 0) {
#pragma unroll
        for (int h = 0; h < 4; ++h) { LAS f32x4* d = (LAS f32x4*)(RED + (w * 4 + h) * 128 + 8 * c);
            d[0] = (f32x4){acc[h][0], acc[h][1], acc[h][2], acc[h][3]}; d[1] = (f32x4){acc[h][4], acc[h][5], acc[h][6], acc[h][7]}; } }
    __syncthreads();
    { float v = 0.f;
#pragma unroll
      for (int ww = 0; ww < 8; ++ww) v += RED[ww * 512 + tid];
      bf16* CC = (bf16*)(F.ws + WS_CONCAT) + (size_t)(NPTOK + s) * DM + 4 * g * 128;
      CC[tid] = (bf16)(cvtpk(v, 0.f) & 0xffffu); }
    __syncthreads();
}

#ifndef MK_N_LAUNCHES
#define MK_N_LAUNCHES 1
#endif
constexpr int N_PHASES = 10;
constexpr int N_LAUNCHES = MK_N_LAUNCHES;

__global__ void __launch_bounds__(NTHREADS, 2) nsa_fwd(Args args) {
    extern __shared__ __attribute__((aligned(16))) unsigned char lds[];
    Frame F;
    F.lds = (LAS unsigned char*)lds;
    F.MISC = (volatile LAS unsigned*)(F.lds + MISC_OFF);
    F.tid = threadIdx.x; F.lane = F.tid & 63; F.wave = __builtin_amdgcn_readfirstlane(F.tid >> 6);
    F.G = gridDim.x; { const int bx = blockIdx.x; F.vcu = (F.G % 8 == 0) ? (bx % 8) * (F.G / 8) + bx / 8 : bx; }
    F.ws = args.ws; F.out = args.out;
    F.ctl = (gu32*)(args.ws + WS_CTL);
    for (int u = F.tid; u < (LDS_BYTES - LDSCTL_OFF) / 4; u += NTHREADS) ((LAS unsigned*)(F.lds + LDSCTL_OFF))[u] = 0u;
    __syncthreads();
    XcdBarrier bar; bar.bar = (unsigned*)(F.ctl + CW_BAR); bar.x = 0; bar.st = nullptr;
    if (N_LAUNCHES == 1) bar = xcd_barrier_post((unsigned*)(F.ctl + CW_BAR), F.MISC + 8);
#define GRID_BAR() do { if (N_LAUNCHES == 1) xcd_barrier(bar); } while (0)
    const int lo = args.ph_lo, hi = args.ph_hi;
#ifndef PH_MASK
#define PH_MASK 0x3ff
#endif
#define IN(k) ((((PH_MASK) >> (k)) & 1) && lo <= (k) && (k) < hi)
#define BOTH(k) (IN(k) && IN((k) + 1))

    if (IN(0)) { p0_prologue(F, args); if (BOTH(0)) GRID_BAR(); }

    if (IN(1)) {
        if (F.vcu == 0 && F.tid < 256) { const float* part = (const float*)(F.ws + WS_CBPART) + (size_t)(F.tid >> 7) * 64 * 128 + (F.tid & 127); float s = 0.f;
            for (int p = 0; p < 64; ++p) s += part[p * 128];
            ((float*)(F.ws + WS_CBIAS))[F.tid] = s; }
        { pg8::Gemm g{(const bf16*)(F.ws + WS_XN), (const bf16*)(F.ws + WS_WIN_T), DM, DM, DM}; pg8::StaticOrder S; S.init(MROWS, NPROJ_PAD, F.G, (int)blockIdx.x);
          EpiProj E{F.ws, F.out, (const float*)(F.ws + WS_ROPE)};
          pg8::gemm_phase<EpiProj, pg8::StaticOrder, true>(F.lds + RING_OFF, g, S, E); }
        { pg8::Gemm g{(const bf16*)(F.ws + WS_CA), (const bf16*)(F.ws + WS_WC1_T), 2048, 2048, 2048}; CmpSOrder S{F.G, (int)blockIdx.x};
          EpiCmpS E{(bf16*)(F.ws + WS_TBS)};
          pg8::gemm_phase<EpiCmpS, CmpSOrder, true>(F.lds + RING_OFF, g, S, E); }
        if (BOTH(1)) GRID_BAR();
    }

    if (IN(2)) {
#ifndef SKIP_A
        { pg8::Gemm g{(const bf16*)(F.ws + WS_KCP), (const bf16*)(F.ws + WS_WC1_T), 256, 2048, 2048}; CmpPOrder S{F.G, (int)blockIdx.x};
          EpiCmpP E{(float*)(F.ws + WS_TBP)};
          pg8::gemm_phase<EpiCmpP, CmpPOrder, true>(F.lds + RING_OFF, g, S, E); }
#endif
#ifndef SKIP_B
        cmp2_phase(F, 0, 512);
#endif
#ifndef SKIP_C
        pool_phase(F, args);
#endif
        if (BOTH(2)) GRID_BAR();
    }

    if (IN(3)) { cmp2_phase(F, 512, 528); if (BOTH(3)) GRID_BAR(); }

    if (IN(4)) {
#ifdef PROBE_COPY
        { const bf16* src = (const bf16*)(F.ws + PROBE_COPY_SRC); for (int i = F.vcu * NTHREADS + F.tid; i < PROBE_COPY_N; i += F.G * NTHREADS) F.out[i] = bf2f(src[i]); }
#endif
#ifdef PROBE_COPYF
        { const float* src = (const float*)(F.ws + PROBE_COPYF_SRC); for (int i = F.vcu * NTHREADS + F.tid; i < PROBE_COPYF_N; i += F.G * NTHREADS) F.out[i] = src[i]; }
#endif
        for (;;) {
            if (F.tid == 0) F.MISC[0] = __hip_atomic_fetch_add((unsigned*)(F.ctl + CW_Q3), 1u, __ATOMIC_RELAXED, __HIP_MEMORY_SCOPE_AGENT);
            __syncthreads();
            const int item = __builtin_amdgcn_readfirstlane((int)F.MISC[0]);
            __syncthreads();
            if (item >= 512) break;
#ifndef SKIP_D
            if (item < 256) { const int ti = 31 - (item >> 3), bg = item & 7; attn_prompt_unit(F, bg >> 1, bg & 1, ti); }
#endif
#ifndef SKIP_E
            if (item >= 256) { const int ix = item - 256; attn_sample_unit(F, args, ix >> 1, ix & 1); }
#endif
        }
        if (BOTH(4)) GRID_BAR();
    }

    if (IN(5)) {
        pg8::Gemm g{(const bf16*)(F.ws + WS_CONCAT), (const bf16*)(F.ws + WS_WO_T), DM, DM, DM}; pg8::StaticOrder S; S.init(MROWS, DM, F.G, (int)blockIdx.x);
        EpiF32SS E{(float*)(F.ws + WS_M), (float*)(F.ws + WS_SSP)};
        pg8::gemm_phase<EpiF32SS, pg8::StaticOrder, true>(F.lds + RING_OFF, g, S, E);
        if (BOTH(5)) GRID_BAR();
    }

    if (IN(6)) { p5_rows(F, args); if (BOTH(6)) GRID_BAR(); }

    if (IN(7)) {
        pg8::Gemm g{(const bf16*)(F.ws + WS_XN), (const bf16*)(F.ws + WS_WUP_T), DM, DM, DM}; pg8::StaticOrder S; S.init(MROWS, DFF, F.G, (int)blockIdx.x);
        EpiUp E{(bf16*)(F.ws + WS_ACT)};
        pg8::gemm_phase<EpiUp, pg8::StaticOrder, true>(F.lds + RING_OFF, g, S, E);
        if (BOTH(7)) GRID_BAR();
    }

    if (IN(8)) {
        pg8::Gemm g{(const bf16*)(F.ws + WS_ACT), (const bf16*)(F.ws + WS_WDN_T), DFF, DFF, DFF}; pg8::StaticOrder S; S.init(MROWS, DM, F.G, (int)blockIdx.x);
        EpiF32SS E{(float*)(F.ws + WS_M), (float*)(F.ws + WS_SSP) + (size_t)MROWS * 32};
        pg8::gemm_phase<EpiF32SS, pg8::StaticOrder, true>(F.lds + RING_OFF, g, S, E);
        if (BOTH(8)) GRID_BAR();
    }

    if (IN(9)) { p8_rows(F, args); }
#undef IN
#undef BOTH
#undef GRID_BAR
}

extern "C" void kernel_launch(void* const* d_in, const int* in_sizes, int n_in, void* d_out, int out_size, void* d_ws, size_t ws_size, hipStream_t stream) {
    static int grid = 0;
    if (grid == 0) {
        if (n_in != 22 || ws_size < WS_END) { fprintf(stderr, "kernel_launch: unexpected shapes (n_in %d, out %d, ws %zu); nothing launched\n", n_in, out_size, ws_size); grid = -1; return; }
        int dev = 0, cus = 0, per_cu = 0;
        if (hipGetDevice(&dev) != hipSuccess || hipDeviceGetAttribute(&cus, hipDeviceAttributeMultiprocessorCount, dev) != hipSuccess) { grid = -1; return; }
        if (hipFuncSetAttribute((const void*)nsa_fwd, hipFuncAttributeMaxDynamicSharedMemorySize, LDS_BYTES) != hipSuccess) { fprintf(stderr, "kernel_launch: hipFuncSetAttribute failed\n"); grid = -1; return; }
        if (hipOccupancyMaxActiveBlocksPerMultiprocessor(&per_cu, (const void*)nsa_fwd, NTHREADS, LDS_BYTES) != hipSuccess || per_cu < 1)
            fprintf(stderr, "kernel_launch: note: occupancy query reports %d workgroups per CU\n", per_cu);
        (void)hipGetLastError();
        grid = cus;
    }
    if (grid < 0) return;
    if (hipMemsetAsync((char*)d_ws + WS_CTL, 0, CTL_ZERO_BYTES, stream) != hipSuccess) { fprintf(stderr, "kernel_launch: memset failed\n"); return; }
    Args a{};
    for (int i = 0; i < 22; ++i) a.in[i] = (const float*)d_in[i];
    a.out = (float*)d_out; a.ws = (unsigned char*)d_ws;
    for (int li = 0; li < N_LAUNCHES; ++li) {
        a.ph_lo = (N_LAUNCHES == 1) ? 0 : li; a.ph_hi = (N_LAUNCHES == 1) ? N_PHASES : li + 1;
        hipLaunchKernelGGL(nsa_fwd, dim3(grid), dim3(NTHREADS), LDS_BYTES, stream, a);
        const hipError_t le = hipPeekAtLastError();
        if (le != hipSuccess) { fprintf(stderr, "kernel_launch: launch %d failed: %s\n", li, hipGetErrorName(le)); break; }
    }
}
```

```cpp
#include <hip/hip_runtime.h>
#include <cstdio>
#include <cstdint>

namespace pg8 {
#define PG8_LAS __attribute__((address_space(3)))
typedef unsigned short bf16_t;
typedef short bf16x8 __attribute__((ext_vector_type(8)));
typedef float f32x4 __attribute__((ext_vector_type(4)));
typedef unsigned u32x4 __attribute__((ext_vector_type(4)));
typedef unsigned u32x2 __attribute__((ext_vector_type(2)));
constexpr int BM = 256, BK = 64, HALF = 128, HTB = HALF * BK * 2  , STAGE_BYTES = 8 * HTB, NXCD = 8, WGM = 8;

__host__ __device__ __forceinline__ int lds_byte(int r, int c) { const int st = (r >> 4) * 2 + (c >> 5), rr = r & 15, cc = c & 31, ob = rr * 64 + cc * 2; return st * 1024 + (ob ^ (((ob >> 9) & 1) << 5)); }
__host__ __device__ __forceinline__ void stage_rc(int b, int& R, int& C) { const int st = b / 1024, sb = b % 1024, swz = sb ^ (((sb >> 9) & 1) << 5); R = (st >> 1) * 16 + swz / 64; C = (st & 1) * 32 + (swz % 64) / 2; }
__host__ __device__ __forceinline__ int perm32(int rho) { const int n = rho >> 4, i = rho & 15; return 8 * (i >> 2) + 4 * n + (i & 3); }

struct Unit { int pm, pn, koff; };
struct Gemm { const bf16_t* A; const bf16_t* Bt; int K, lda, ldb; };

struct StaticOrder {
    int nM, nN, nwg, G, c;
    __host__ __device__ void init(int M, int N, int G_, int c_) { nM = M / BM; nN = N / BM; nwg = nM * nN; G = G_; c = c_; }
    __host__ __device__ bool next(int i, Unit& u) const {
        const long L = (long)i * G + c; if (L >= nwg) return false;
        int wgid = (int)L; { const int q = nwg / NXCD, r = nwg % NXCD, xcd = wgid % NXCD, off = wgid / NXCD; wgid = (xcd < r ? xcd * (q + 1) : r * (q + 1) + (xcd - r) * q) + off; }
        const int nig = WGM * nN, gid = wgid / nig, fm = gid * WGM, gsz = (nM - fm) < WGM ? (nM - fm) : WGM;
        u.pm = fm + ((wgid % nig) % gsz); u.pn = (wgid % nig) / gsz; u.koff = 0; return true;
    }
    __device__ __forceinline__ void a_ready(const Unit&) const {}
    __device__ __forceinline__ void done(const Unit&) const {}
};

__device__ __forceinline__ unsigned cvt_pk_bf16(float lo, float hi) { unsigned r; asm volatile("v_cvt_pk_bf16_f32 %0, %1, %2" : "=v"(r) : "v"(lo), "v"(hi)); return r; }

template <class Epi, class Sched, bool ALIGN_EPI>
__device__ __forceinline__ void gemm_phase(PG8_LAS unsigned char* lds, const Gemm g, const Sched& S, const Epi& E) {
    const int tid = threadIdx.x, wid = __builtin_amdgcn_readfirstlane(tid >> 6), lane = tid & 63, wr = wid >> 2, wc = wid & 3, fr = lane & 15, fq = lane >> 4;
    const int K = g.K, nt = K / BK;
    unsigned voffA[2], voffB[2];
#pragma unroll
    for (int i = 0; i < 2; ++i) { int R, C; stage_rc(tid * 16 + i * 8192, R, C); const int Rb = Epi::PERM ? ((R & ~31) + perm32(R & 31)) : R;
        voffA[i] = (unsigned)(R * g.lda + C) * 2u; voffB[i] = (unsigned)(Rb * g.ldb + C) * 2u; }
    const size_t kstep = (size_t)(BK * 2);
    const size_t hstepA = (size_t)HALF * g.lda * 2, hstepB = (size_t)HALF * g.ldb * 2;
    const size_t tstepA = 2 * hstepA, tstepB = 2 * hstepB;
    const unsigned ldsw = (unsigned)wid * 1024u;
    const int aoff = lds_byte(wr * 64 + fr, fq * 8), boff = lds_byte(wc * 32 + fr, fq * 8);
#define PG8_SA(b, h) (((b) * 2 + (h)) * HTB)
#define PG8_SB(b, h) ((4 + (b) * 2 + (h)) * HTB)
#define PG8_STAGE(bufoff, gbase, voff) do { _Pragma("unroll") for (int _i = 0; _i < 2; ++_i) \
        __builtin_amdgcn_global_load_lds((const unsigned*)((const char*)(gbase) + (voff)[_i]), (PG8_LAS unsigned*)(lds + (bufoff) + ldsw + _i * 8192), 16, 0, 0); } while (0)
#define PG8_LDA(dst, b, h) do { _Pragma("unroll") for (int m = 0; m < 4; ++m) _Pragma("unroll") for (int k = 0; k < 2; ++k) dst[m][k] = *(const PG8_LAS bf16x8*)(lds + PG8_SA(b, h) + aoff + m * 2048 + k * 1024); } while (0)
#define PG8_LDB(dst, b, h) do { _Pragma("unroll") for (int n = 0; n < 2; ++n) _Pragma("unroll") for (int k = 0; k < 2; ++k) dst[n][k] = *(const PG8_LAS bf16x8*)(lds + PG8_SB(b, h) + boff + n * 2048 + k * 1024); } while (0)
#define PG8_MMA(ai, bj, At, Bt) do { __builtin_amdgcn_s_setprio(1); _Pragma("unroll") for (int m = 0; m < 4; ++m) _Pragma("unroll") for (int n = 0; n < 2; ++n) _Pragma("unroll") for (int k = 0; k < 2; ++k) \
        acc[ai][bj][m][n] = __builtin_amdgcn_mfma_f32_16x16x32_bf16(Bt[n][k], At[m][k], acc[ai][bj][m][n], 0, 0, 0); __builtin_amdgcn_s_setprio(0); } while (0)
#define PG8_WAIT_V(n) asm volatile("s_waitcnt vmcnt(" #n ")" ::: "memory")
#define PG8_WAIT_L(n) asm volatile("s_waitcnt lgkmcnt(" #n ")" ::: "memory")
#define PG8_BAR __builtin_amdgcn_s_barrier()
#define PG8_SCHED __builtin_amdgcn_sched_barrier(0)
    Unit cur, nxt; int ui = 0;
    if (!S.next(0, cur)) return;
    f32x4 acc[2][2][4][2];
#pragma unroll
    for (int a = 0; a < 2; ++a)
#pragma unroll
        for (int b = 0; b < 2; ++b)
#pragma unroll
            for (int m = 0; m < 4; ++m)
#pragma unroll
                for (int n = 0; n < 2; ++n) acc[a][b][m][n] = (f32x4){0.f, 0.f, 0.f, 0.f};
    bf16x8 At[4][2], B0[2][2], B1[2][2];
    const char* cA = (const char*)g.A + (size_t)cur.pm * tstepA + (size_t)cur.koff * 2; const char* cB = (const char*)g.Bt + (size_t)cur.pn * tstepB + (size_t)cur.koff * 2;
    S.a_ready(cur);
    PG8_STAGE(PG8_SB(0, 0), cB, voffB); PG8_STAGE(PG8_SB(0, 1), cB + hstepB, voffB); PG8_STAGE(PG8_SA(0, 0), cA, voffA); PG8_STAGE(PG8_SA(0, 1), cA + hstepA, voffA);
    if (wr == 1) PG8_BAR;
    PG8_WAIT_V(2); PG8_BAR;
    PG8_STAGE(PG8_SB(1, 0), cB + kstep, voffB); PG8_STAGE(PG8_SA(1, 0), cA + kstep, voffA); PG8_STAGE(PG8_SB(1, 1), cB + hstepB + kstep, voffB);
    PG8_WAIT_V(6); PG8_BAR;
    for (;;) {
        const bool has_next = S.next(ui + 1, nxt);
        const char* nA = has_next ? (const char*)g.A + (size_t)nxt.pm * tstepA + (size_t)nxt.koff * 2 : cA; const char* nB = has_next ? (const char*)g.Bt + (size_t)nxt.pn * tstepB + (size_t)nxt.koff * 2 : cB;
        for (int t = 0; t < nt; t += 2) {
            const bool last = (t == nt - 2);
            const char* a1 = cA + (size_t)(t + 1) * kstep;
            const char* a2 = last ? nA : cA + (size_t)(t + 2) * kstep; const char* b2 = last ? nB : cB + (size_t)(t + 2) * kstep;
            const char* a3 = a2 + kstep; const char* b3 = b2 + kstep;
            if (last && has_next) S.a_ready(nxt);
            PG8_LDB(B0, 0, 0); PG8_LDB(B1, 0, 1); PG8_SCHED; PG8_LDA(At, 0, 0); PG8_STAGE(PG8_SA(1, 1), a1 + hstepA, voffA);
            PG8_WAIT_V(8); PG8_WAIT_L(0); PG8_BAR; PG8_MMA(0, 0, At, B0); PG8_MMA(0, 1, At, B1); PG8_BAR; PG8_SCHED;
            PG8_LDA(At, 0, 1); PG8_STAGE(PG8_SB(0, 0), b2, voffB); PG8_STAGE(PG8_SB(0, 1), b2 + hstepB, voffB); PG8_STAGE(PG8_SA(0, 0), a2, voffA);
            PG8_WAIT_V(8); PG8_WAIT_L(0); PG8_BAR; PG8_MMA(1, 0, At, B0); PG8_MMA(1, 1, At, B1); PG8_BAR; PG8_SCHED;
            PG8_LDB(B0, 1, 0); PG8_LDB(B1, 1, 1); PG8_SCHED; PG8_LDA(At, 1, 0); PG8_STAGE(PG8_SA(0, 1), a2 + hstepA, voffA);
            PG8_WAIT_V(8); PG8_WAIT_L(0); PG8_BAR; PG8_MMA(0, 0, At, B0); PG8_MMA(0, 1, At, B1); PG8_BAR; PG8_SCHED;
            PG8_LDA(At, 1, 1); PG8_STAGE(PG8_SB(1, 0), b3, voffB); PG8_STAGE(PG8_SB(1, 1), b3 + hstepB, voffB); PG8_STAGE(PG8_SA(1, 0), a3, voffA);
            PG8_WAIT_V(8); PG8_WAIT_L(0); PG8_BAR; PG8_MMA(1, 0, At, B0); PG8_MMA(1, 1, At, B1); PG8_BAR; PG8_SCHED;
        }
        if constexpr (ALIGN_EPI) { if (wr == 0) PG8_BAR; }
        if constexpr (!Epi::AFTER_DRAIN) { E(acc, cur, wr, wc, fr, fq); S.done(cur); }
        if (!has_next) break;
#pragma unroll
        for (int a = 0; a < 2; ++a)
#pragma unroll
            for (int b = 0; b < 2; ++b)
#pragma unroll
                for (int m = 0; m < 4; ++m)
#pragma unroll
                    for (int n = 0; n < 2; ++n) acc[a][b][m][n] = (f32x4){0.f, 0.f, 0.f, 0.f};
        cur = nxt; cA = nA; cB = nB; ++ui;
        if constexpr (ALIGN_EPI) { if (wr == 1) PG8_BAR; }
    }
    PG8_WAIT_V(0);
    if constexpr (!ALIGN_EPI) { if (wr == 0) PG8_BAR; }
    PG8_BAR;
    if constexpr (Epi::AFTER_DRAIN) { E.fused(acc, cur, wr, wc, fr, fq, lds, wid, lane); S.done(cur); }
#undef PG8_SA
#undef PG8_SB
#undef PG8_STAGE
#undef PG8_LDA
#undef PG8_LDB
#undef PG8_MMA
#undef PG8_WAIT_V
#undef PG8_WAIT_L
#undef PG8_BAR
#undef PG8_SCHED
}
}
#define GAS __attribute__((address_space(1)))
#define LAS __attribute__((address_space(3)))
typedef unsigned short bf16;
typedef unsigned v4u __attribute__((ext_vector_type(4)));
typedef float f32x4 __attribute__((ext_vector_type(4)));
typedef short bf16x8 __attribute__((ext_vector_type(8)));
typedef GAS unsigned gu32;
typedef GAS unsigned long long gu64;
#define RLX_AGENT __ATOMIC_RELAXED, __HIP_MEMORY_SCOPE_AGENT
#define LDS_WAIT() asm volatile("s_waitcnt lgkmcnt(0)" ::: "memory")
#define VM_WAIT() asm volatile("s_waitcnt vmcnt(0)" ::: "memory")
__device__ __forceinline__ unsigned long long rt() { return __builtin_amdgcn_s_memrealtime(); }
__device__ __forceinline__ unsigned f2bf(float f) { unsigned u = __builtin_bit_cast(unsigned, f); return (u + 0x7fffu + ((u >> 16) & 1u)) >> 16; }
__device__ __forceinline__ unsigned pk2(float lo, float hi) { return f2bf(lo) | (f2bf(hi) << 16); }

#define XB_TMO      128
#define XB_XCNT(j)  (256  + 64 * (j))
#define XB_XSUB(j)  (1280 + 64 * (j))
#define XB_XGEN(j)  (2304 + 64 * (j))
#define XB_TOP      3328
#define XB_TOPGEN   3392
#define XCD_BAR_WORDS 3456
#define XB_SPIN_CAP (1u << 18)

__device__ __forceinline__ unsigned xb_ld(unsigned* p)              { return __hip_atomic_load(p, __ATOMIC_RELAXED, __HIP_MEMORY_SCOPE_AGENT); }
__device__ __forceinline__ unsigned xb_add(unsigned* p, unsigned v) { return __hip_atomic_fetch_add(p, v, __ATOMIC_RELAXED, __HIP_MEMORY_SCOPE_AGENT); }
__device__ __forceinline__ unsigned xb_xcc_id() { return (unsigned)__builtin_amdgcn_s_getreg((3 << 11) | 20) & 0xFu; }
#define XB_SPIN(cond, bar) do { unsigned _sp = 0; while (cond) { __builtin_amdgcn_s_sleep(1); \
    if ((++_sp & 255u) == 0u) { if (xb_ld(&(bar)[XB_TMO])) break; if (_sp > XB_SPIN_CAP) { atomicAdd(&(bar)[XB_TMO], 1u); break; } } } } while (0)

struct XcdBarrier {
    unsigned* bar; unsigned x;
    volatile LAS unsigned* st;
};

__device__ __forceinline__ XcdBarrier xcd_barrier_post(unsigned* bar, volatile LAS unsigned* st) {
    XcdBarrier b; b.bar = bar; b.x = xb_xcc_id(); b.st = st;
    if (threadIdx.x == 0) (void)xb_add(&bar[XB_XCNT(b.x)], 1u);
    return b;
}
__device__ __forceinline__ void xcd_barrier_complete(unsigned* bar, unsigned x, unsigned& nloc, unsigned& nx) {
    const unsigned G = gridDim.x * gridDim.y * gridDim.z;
    unsigned sum, cnt, mine, sp = 0u;
    for (;;) {
        sum = 0u; cnt = 0u; mine = 0u;
#pragma unroll
        for (unsigned j = 0; j < 16; ++j) { const unsigned c = xb_ld(&bar[XB_XCNT(j)]); sum += c; cnt += (c > 0u) ? 1u : 0u; mine = (j == x) ? c : mine; }
        if (sum == G) break;
        __builtin_amdgcn_s_sleep(1);
        if ((++sp & 255u) == 0u) { if (xb_ld(&bar[XB_TMO])) break; if (sp > XB_SPIN_CAP) { atomicAdd(&bar[XB_TMO], 1u); break; } }
    }
    nloc = mine > 0u ? mine : 1u; nx = cnt > 0u ? cnt : 1u;
}

__device__ __forceinline__ void xcd_barrier(const XcdBarrier& b) {
    asm volatile("s_waitcnt vmcnt(0)" ::: "memory");
    __syncthreads();
    if (threadIdx.x == 0) {
        unsigned* bar = b.bar;
        __builtin_amdgcn_s_waitcnt(0);
        unsigned nloc = b.st[0], nx = b.st[1];
        if (nloc == 0u) { xcd_barrier_complete(bar, b.x, nloc, nx); b.st[0] = nloc; b.st[1] = nx; }
        const unsigned old = xb_add(&bar[XB_XSUB(b.x)], 1u);
        const unsigned gen = old / nloc;
        if (old + 1u == (gen + 1u) * nloc) {
            __builtin_amdgcn_fence(__ATOMIC_RELEASE, "agent");
            asm volatile("s_waitcnt vmcnt(0)" ::: "memory");
            const unsigned og = xb_add(&bar[XB_TOP], 1u);
            const unsigned tg = og / nx;
            if (og + 1u == (tg + 1u) * nx) xb_add(&bar[XB_TOPGEN], 1u);
            else XB_SPIN(xb_ld(&bar[XB_TOPGEN]) == tg, bar);
            __builtin_amdgcn_fence(__ATOMIC_ACQUIRE, "agent");
            xb_add(&bar[XB_XGEN(b.x)], 1u);
            asm volatile("s_waitcnt vmcnt(0)" ::: "memory");
        } else {
            XB_SPIN(xb_ld(&bar[XB_XGEN(b.x)]) == gen, bar);
            __builtin_amdgcn_fence(__ATOMIC_ACQUIRE, "agent");
            asm volatile("s_waitcnt vmcnt(0)" ::: "memory");
        }
    }
    __syncthreads();
}


constexpr int NWAVES = 8, NTHREADS = 512;
constexpr int DM = 2048, NPTOK = 8192, SEQ = 2048, NB = 4, NS = 128, MTOK = NPTOK + NS  , MROWS = 8448  ;
constexpr int NPROJ = 3608, NPROJ_PAD = 3840, DFF = 8192;
constexpr int NHEAD = 8, HD = 128, NG = 2, HPG = 4;
constexpr int NCMP = 127, NSEL_P = 32, NSEL_S = 33, TOPK = 16;
constexpr int NPAGES = 16, PAGE = 128, PAST = 2048, WB = 512;
constexpr float EPS = 1e-6f;
constexpr float SM_SCALE = 0.08838834764831845f;
constexpr float SM_C2 = SM_SCALE * 1.4426950408889634f;

constexpr size_t O_YP = 0, O_YS = O_YP + (size_t)NPTOK * DM, O_KVP = O_YS + (size_t)NS * DM, O_KVS = O_KVP + (size_t)NPTOK * 1024,
                 O_WINP = O_KVS + (size_t)NS * 1024, O_WINS = O_WINP + (size_t)NB * 512 * 512, O_POOLP = O_WINS + (size_t)NS * 512 * 512,
                 O_POOLS = O_POOLP + (size_t)NB * 15 * 1024, O_END = O_POOLS + (size_t)NS * 15 * 1024;

constexpr size_t MiB = 1u << 20;
constexpr size_t WS_CTL = 0, CTL_ZERO_BYTES = 1 * MiB;
constexpr size_t WS_WIN_T = 2 * MiB;
constexpr size_t WS_WO_T = 18 * MiB;
constexpr size_t WS_WUP_T = 26 * MiB;
constexpr size_t WS_WDN_T = 58 * MiB;
constexpr size_t WS_WC1_T = 90 * MiB;
constexpr size_t WS_WC2_T = 92 * MiB;
constexpr size_t WS_POOLW_T = 92 * MiB + 256 * 1024;
constexpr size_t WS_ROPE = 93 * MiB;
constexpr size_t WS_XN = 96 * MiB;
constexpr size_t WS_Q = 130 * MiB;
constexpr size_t WS_KCP = 148 * MiB;
constexpr size_t WS_KS = 156 * MiB;
constexpr size_t WS_VST = 160 * MiB;
constexpr size_t WS_KW = 164 * MiB;
constexpr size_t WS_VWT = 168 * MiB;
constexpr size_t WS_U = 172 * MiB;
constexpr size_t WS_GATES = 190 * MiB;
constexpr size_t WS_TBP = 760 * MiB;
constexpr size_t WS_CMPP = 195 * MiB;
constexpr size_t WS_CMPS = 196 * MiB;
constexpr size_t WS_TBS = 216 * MiB;
constexpr size_t WS_CA = 256 * MiB;
constexpr size_t WS_CONCAT = 520 * MiB;
constexpr size_t WS_M = 556 * MiB;
constexpr size_t WS_M2 = 590 * MiB;
constexpr size_t WS_ACT = 624 * MiB;
constexpr size_t WS_CBPART = 776 * MiB;
constexpr size_t WS_CBIAS = 776 * MiB + 128 * 1024;
constexpr size_t WS_SSP = 777 * MiB;
constexpr size_t WS_WC1F = 782 * MiB;
constexpr size_t WS_XCH = 780 * MiB;
constexpr size_t WS_END = 784 * MiB;
constexpr int CW_TMO = 0, CW_CODE = 1;
constexpr int CW_BAR = 4096;
constexpr int CW_Q3 = 8192;
constexpr int CW_QT = 12288;
constexpr int CW_CBIAS = 8448;
constexpr int CW_SS1 = 16384;
constexpr int CW_SS2 = 32768;
constexpr int CW_XC = 65536;
static_assert((CW_XC + 3 * 4096) * 4 <= (int)CTL_ZERO_BYTES, "CTL");

constexpr int RING_OFF = 0, RING_BYTES = 131072;
constexpr int LDS_BYTES = 147456;
constexpr int LDSCTL_OFF = LDS_BYTES - 1024, MISC_OFF = LDSCTL_OFF + 320;

typedef unsigned u32x2v __attribute__((ext_vector_type(2)));
typedef float f32x2v __attribute__((ext_vector_type(2)));
struct Args { const float* in[22]; float* out; unsigned char* ws; int ph_lo, ph_hi, rep, pad; };
struct Frame {
    LAS unsigned char* lds;
    volatile LAS unsigned* MISC;
    gu32* ctl;
    unsigned char* ws;
    float* out;
    int tid, lane, wave;
    int vcu, G;
};

__device__ __forceinline__ int fresh_tid(const Frame& F) { int l; asm volatile("v_mbcnt_lo_u32_b32 %0, -1, 0\n\tv_mbcnt_hi_u32_b32 %0, -1, %0" : "=v"(l)); return F.wave * 64 + l; }
template <int CTRL> __device__ __forceinline__ float dpp_f(float v) { return __int_as_float(__builtin_amdgcn_update_dpp(0, __float_as_int(v), CTRL, 0xf, 0xf, true)); }
__device__ __forceinline__ float row_sum16(float v) { v += dpp_f<0x128>(v); v += dpp_f<0x124>(v); v += dpp_f<0x122>(v); v += dpp_f<0x121>(v); return v; }
__device__ __forceinline__ float row_max16(float v) { v = fmaxf(v, dpp_f<0x128>(v)); v = fmaxf(v, dpp_f<0x124>(v)); v = fmaxf(v, dpp_f<0x122>(v)); v = fmaxf(v, dpp_f<0x121>(v)); return v; }
__device__ __forceinline__ float quad_sum(float v) { v += dpp_f<0xB1>(v); v += dpp_f<0x4E>(v); return v; }
__device__ __forceinline__ float xmax4(float v) {
    { auto r = __builtin_amdgcn_permlane32_swap(__float_as_uint(v), __float_as_uint(v), false, false); v = fmaxf(__uint_as_float(r[0]), __uint_as_float(r[1])); }
    { auto r = __builtin_amdgcn_permlane16_swap(__float_as_uint(v), __float_as_uint(v), false, false); v = fmaxf(__uint_as_float(r[0]), __uint_as_float(r[1])); }
    return v;
}
__device__ __forceinline__ float xsum4(float v) {
    { auto r = __builtin_amdgcn_permlane32_swap(__float_as_uint(v), __float_as_uint(v), false, false); v = __uint_as_float(r[0]) + __uint_as_float(r[1]); }
    { auto r = __builtin_amdgcn_permlane16_swap(__float_as_uint(v), __float_as_uint(v), false, false); v = __uint_as_float(r[0]) + __uint_as_float(r[1]); }
    return v;
}
__device__ __forceinline__ unsigned xor4(unsigned v) {
    { auto r = __builtin_amdgcn_permlane32_swap(v, v, false, false); v = r[0] | r[1]; }
    { auto r = __builtin_amdgcn_permlane16_swap(v, v, false, false); v = r[0] | r[1]; }
    return v;
}
__device__ __forceinline__ float from_prev_row(float x, int row) {
    const auto s1 = __builtin_amdgcn_permlane16_swap(__float_as_uint(x), __float_as_uint(x), false, false);
    const auto s2 = __builtin_amdgcn_permlane32_swap(s1[1], s1[1], false, false);
    return __uint_as_float((row & 1) ? s1[0] : (row == 0 ? s2[1] : s2[0]));
}
__device__ __forceinline__ float wave_sum(float v) { return xsum4(row_sum16(v)); }
__device__ __forceinline__ float wave_max(float v) { return xmax4(row_max16(v)); }
typedef __bf16 bf16x2_t __attribute__((ext_vector_type(2)));
__device__ __forceinline__ unsigned cvtpk(float lo, float hi) { const f32x2v v = {lo, hi}; const bf16x2_t b = __builtin_convertvector(v, bf16x2_t); return __builtin_bit_cast(unsigned, b); }
__device__ __forceinline__ float bf_lo(unsigned w) { return __uint_as_float(w << 16); }
__device__ __forceinline__ float bf_hi(unsigned w) { return __uint_as_float(w & 0xffff0000u); }
__device__ __forceinline__ float bf2f(bf16 h) { return __uint_as_float(((unsigned)h) << 16); }

struct TDesc { const float* W; bf16* WT; const float* gain; int N, ldw, ldt, row_off, mode, item; };
__device__ __forceinline__ void p0_t_load(const TDesc& d, float (&v)[32], int lane) {
    const int nblk = (d.N + 31) / 32, kb = d.item / nblk, nb = d.item % nblk, k0 = 64 * kb, n0 = 32 * nb, nn = n0 + (lane & 31);
#pragma unroll
    for (int i = 0; i < 32; ++i) { const int kk = 2 * i + (lane >> 5); v[i] = (nn < d.N) ? __builtin_nontemporal_load(d.W + (size_t)(k0 + kk) * d.ldw + nn) : 0.f; }
}
__device__ __forceinline__ void p0_t_finish(const TDesc& d, const float (&v)[32], LAS float* scr, int lane) {
    const int nblk = (d.N + 31) / 32, kb = d.item / nblk, nb = d.item % nblk, k0 = 64 * kb, n0 = 32 * nb;
#pragma unroll
    for (int i = 0; i < 32; ++i) { const int kk = 2 * i + (lane >> 5); float x = v[i]; if (d.gain) x *= d.gain[k0 + kk]; scr[kk * 33 + (lane & 31)] = x; }
    LDS_WAIT(); asm volatile("" ::: "memory");
    const int c = lane & 7;
#pragma unroll
    for (int j = 0; j < 4; ++j) { const int nl = (lane >> 3) + 8 * j, n = n0 + nl; const LAS float* s = scr + (8 * c) * 33 + nl;
        if (n < d.N) {
            int dest = n;
            if (d.mode == 1) dest = (n < 2560) ? n : ((n < 2584) ? (3584 + (n - 2560)) : (n - 24));
            v4u o; o.x = cvtpk(s[0 * 33], s[1 * 33]); o.y = cvtpk(s[2 * 33], s[3 * 33]); o.z = cvtpk(s[4 * 33], s[5 * 33]); o.w = cvtpk(s[6 * 33], s[7 * 33]);
            *(v4u*)(d.WT + (size_t)(d.row_off + dest) * d.ldt + k0 + 8 * c) = o; } }
    LDS_WAIT(); asm volatile("" ::: "memory");
}
constexpr int TI_IN = 32 * 113, TI_O = 32 * 64, TI_UP = 32 * 256, TI_DN = 128 * 64, TI_C1 = 32 * 4, TI_C2 = 2 * 4, TI_PW = 4 * 8;
constexpr int TI_SMALL = TI_IN + TI_O + 4 * TI_C1 + 2 * TI_C2 + 4 * TI_PW;
constexpr int TI_ALL = TI_SMALL + TI_DN + TI_UP;
__device__ __forceinline__ TDesc p0_t_decode(const Args& A, unsigned char* ws, int it) {
    TDesc d; d.gain = nullptr; d.mode = 0; d.row_off = 0;
    int r = it;
    if (r < TI_IN) { d.W = A.in[7]; d.N = NPROJ; d.ldw = NPROJ; d.WT = (bf16*)(ws + WS_WIN_T); d.ldt = DM; d.gain = A.in[6]; d.mode = 1; d.item = r; return d; } r -= TI_IN;
    if (r < TI_O) { d.W = A.in[16]; d.N = DM; d.ldw = DM; d.WT = (bf16*)(ws + WS_WO_T); d.ldt = DM; d.item = r; return d; } r -= TI_O;
    if (r < 4 * TI_C1) { const int kind = r / (2 * TI_C1), half = (r / TI_C1) & 1;
        d.W = A.in[kind ? 12 : 9] + (size_t)half * 2048 * 128; d.N = 128; d.ldw = 128; d.WT = (bf16*)(ws + WS_WC1_T) + (size_t)kind * 256 * 2048; d.ldt = 2048; d.row_off = half * 128; d.item = r % TI_C1; return d; } r -= 4 * TI_C1;
    if (r < 2 * TI_C2) { const int kind = r / TI_C2; d.W = A.in[kind ? 13 : 10]; d.N = 128; d.ldw = 128; d.WT = (bf16*)(ws + WS_WC2_T) + (size_t)kind * 128 * 128; d.ldt = 128; d.item = r % TI_C2; return d; } r -= 2 * TI_C2;
    if (r < 4 * TI_PW) { const int g = r / TI_PW; d.W = A.in[14] + (size_t)g * 256 * 256; d.N = 256; d.ldw = 256; d.WT = (bf16*)(ws + WS_POOLW_T) + (size_t)g * 256 * 256; d.ldt = 256; d.item = r % TI_PW; return d; } r -= 4 * TI_PW;
    if (r < TI_DN) { d.W = A.in[20]; d.N = DM; d.ldw = DM; d.WT = (bf16*)(ws + WS_WDN_T); d.ldt = DFF; d.item = r; return d; } r -= TI_DN;
    { d.W = A.in[19]; d.N = DFF; d.ldw = DFF; d.WT = (bf16*)(ws + WS_WUP_T); d.ldt = DM; d.gain = A.in[18]; d.item = r; return d; }
}
__device__ __forceinline__ void p0_transposes(Frame& F, const Args& A, int lo, int hi, int vlo) {
    if (F.vcu < vlo) return;
    LAS float* scr = (LAS float*)(F.lds + RING_OFF + F.wave * 16384);
    const int gw = (F.vcu - vlo) * NWAVES + F.wave, NGW = (F.G - vlo) * NWAVES;
    for (int it = lo + 2 * gw; it < hi; it += 2 * NGW) {
        const TDesc d0 = p0_t_decode(A, F.ws, it); const bool two = (it + 1) < hi; const TDesc d1 = p0_t_decode(A, F.ws, two ? it + 1 : it);
        float v0[32], v1[32];
        p0_t_load(d0, v0, F.lane); if (two) p0_t_load(d1, v1, F.lane);
        p0_t_finish(d0, v0, scr, F.lane); if (two) p0_t_finish(d1, v1, scr, F.lane);
    }
}

__device__ __forceinline__ void p0_pair_load(const TDesc& d, f32x4 (&v)[16], f32x4 (&g8)[2], int lane) {
    const int nblk = (d.N + 31) / 32, kb = d.item / nblk, nb = d.item % nblk, k0 = 64 * kb, n0 = 32 * nb;
    const float* gp = (d.gain ? d.gain : d.W) + k0 + 8 * (lane & 7);
    g8[0] = *(const f32x4*)gp; g8[1] = *(const f32x4*)(gp + 4);
    const float* base = d.W + (size_t)(k0 + (lane >> 4)) * d.ldw + n0 + 4 * (lane & 15);
#pragma unroll
    for (int i = 0; i < 16; ++i) v[i] = __builtin_nontemporal_load((const f32x4*)(base + (size_t)(4 * i) * d.ldw));
}
__device__ __forceinline__ void p0_pair_finish(const TDesc& d, const f32x4 (&v)[16], const f32x4 (&g8)[2], LAS float* scr, int lane) {
    const int nblk = (d.N + 31) / 32, kb = d.item / nblk, nb = d.item % nblk, k0 = 64 * kb, n0 = 32 * nb;
#pragma unroll
    for (int i = 0; i < 16; ++i) { const int kk = 4 * i + (lane >> 4); const f32x4 x = v[i];
        LAS float* w = scr + kk * 65 + 4 * (lane & 15); w[0] = x[0]; w[1] = x[1]; w[2] = x[2]; w[3] = x[3]; }
    LDS_WAIT(); asm volatile("" ::: "memory");
    const int c = lane & 7; const bool hg = d.gain != nullptr;
    float gk[8];
#pragma unroll
    for (int e = 0; e < 4; ++e) { gk[e] = hg ? g8[0][e] : 1.f; gk[4 + e] = hg ? g8[1][e] : 1.f; }
#pragma unroll
    for (int j = 0; j < 8; ++j) { const int nl = (lane >> 3) + 8 * j; const LAS float* s = scr + (8 * c) * 65 + nl;
        v4u o; o.x = cvtpk(s[0 * 65] * gk[0], s[1 * 65] * gk[1]); o.y = cvtpk(s[2 * 65] * gk[2], s[3 * 65] * gk[3]); o.z = cvtpk(s[4 * 65] * gk[4], s[5 * 65] * gk[5]); o.w = cvtpk(s[6 * 65] * gk[6], s[7 * 65] * gk[7]);
        *(v4u*)(d.WT + (size_t)(d.row_off + n0 + nl) * d.ldt + k0 + 8 * c) = o; }
    LDS_WAIT(); asm volatile("" ::: "memory");
}
__device__ __forceinline__ int t_pop(Frame& F, unsigned* qword) {
    if (fresh_tid(F) == 0) F.MISC[1] = __hip_atomic_fetch_add(qword, 1u, __ATOMIC_RELAXED, __HIP_MEMORY_SCOPE_AGENT);
    asm volatile("s_waitcnt lgkmcnt(0)" ::: "memory"); __builtin_amdgcn_s_barrier(); asm volatile("" ::: "memory");
    const int c = __builtin_amdgcn_readfirstlane((int)F.MISC[1]);
    asm volatile("s_waitcnt lgkmcnt(0)" ::: "memory"); __builtin_amdgcn_s_barrier(); asm volatile("" ::: "memory");
    return c;
}
constexpr int T_SCR = 18304;
static_assert(8 * T_SCR <= LDSCTL_OFF, "transposition LDS");
__device__ __forceinline__ void p0_transposes_dyn(Frame& F, const Args& A, int lo, int hi, unsigned* qword) {
    LAS float* scr = (LAS float*)(F.lds + RING_OFF + F.wave * T_SCR);
    const int lane = fresh_tid(F) & 63;
    int c = t_pop(F, qword);
    if (lo + 16 * c >= hi) return;
    TDesc da = p0_t_decode(A, F.ws, lo + 16 * c + 2 * F.wave), db = da;
    f32x4 va[16], vb[16], ga[2], gb[2];
    p0_pair_load(da, va, ga, lane);
    for (;;) {
        c = t_pop(F, qword); const bool vn = lo + 16 * c < hi;
        db = p0_t_decode(A, F.ws, lo + 16 * (vn ? c : 0) + 2 * F.wave); p0_pair_load(db, vb, gb, lane);
        p0_pair_finish(da, va, ga, scr, lane);
        if (!vn) break;
        c = t_pop(F, qword); const bool v2 = lo + 16 * c < hi;
        da = p0_t_decode(A, F.ws, lo + 16 * (v2 ? c : 0) + 2 * F.wave); p0_pair_load(da, va, ga, lane);
        p0_pair_finish(db, vb, gb, scr, lane);
        if (!v2) break;
    }
}
__device__ __forceinline__ void p0_prologue(Frame& F, const Args& A) {
    const int gw = F.vcu * NWAVES + F.wave, NGW = F.G * NWAVES;
    const int gt = F.vcu * NTHREADS + F.tid, NGT = F.G * NTHREADS;
    unsigned char* ws = F.ws;
    p0_transposes(F, A, 0, TI_SMALL, 0);
    { v4u z = {0u, 0u, 0u, 0u};
      v4u* p = (v4u*)(ws + WS_WIN_T + (size_t)NPROJ * DM * 2); const int n1 = (NPROJ_PAD - NPROJ) * DM * 2 / 16;
      for (int i = gt; i < n1; i += NGT) p[i] = z;
      v4u* xz = (v4u*)(ws + WS_XN + (size_t)MTOK * DM * 2); const int n3 = (MROWS - MTOK) * DM * 2 / 16;
      for (int i = gt; i < n3; i += NGT) xz[i] = z; }
    for (int m0 = gw; m0 < MTOK; m0 += 2 * NGW) {
        f32x4 v[2][8]; float s[2] = {0.f, 0.f};
#pragma unroll
        for (int u = 0; u < 2; ++u) { const int m = m0 + u * NGW;
            if (m < MTOK) { const float* xrow = (m < NPTOK) ? A.in[0] + (size_t)m * DM : A.in[1] + (size_t)(m - NPTOK) * DM; const f32x4* xr = (const f32x4*)xrow + F.lane;
#pragma unroll
                for (int j = 0; j < 8; ++j) v[u][j] = __builtin_nontemporal_load(xr + 64 * j); }
            else {
#pragma unroll
                for (int j = 0; j < 8; ++j) v[u][j] = (f32x4){0.f, 0.f, 0.f, 0.f}; } }
#pragma unroll
        for (int u = 0; u < 2; ++u) {
#pragma unroll
            for (int j = 0; j < 8; ++j) s[u] += (v[u][j].x * v[u][j].x + v[u][j].y * v[u][j].y) + (v[u][j].z * v[u][j].z + v[u][j].w * v[u][j].w); }
#pragma unroll
        for (int u = 0; u < 2; ++u) { const int m = m0 + u * NGW;
            const float rstd = 1.f / sqrtf(wave_sum(s[u]) * (1.f / DM) + EPS);
            if (m < MTOK) { u32x2v* o8 = (u32x2v*)((bf16*)(ws + WS_XN) + (size_t)m * DM) + F.lane;
#pragma unroll
                for (int j = 0; j < 8; ++j) { u32x2v w; w.x = cvtpk(v[u][j].x * rstd, v[u][j].y * rstd); w.y = cvtpk(v[u][j].z * rstd, v[u][j].w * rstd); o8[64 * j] = w; } } }
    }
    { float* rope = (float*)(ws + WS_ROPE);
      for (int i = gt; i < 2049 * 16; i += NGT) { const int pos = i >> 4, k = i & 15;
          const float inv = exp2f(-(float)k * (18.931568569324174f / 16.f));
          const float ang = (float)pos * inv;
          const float kk = rintf(ang * 0.15915494309189535f);
          float r = fmaf(-kk, 6.28125f, ang); r = fmaf(-kk, 1.9353071795864769e-3f, r);
          rope[pos * 32 + k] = __cosf(r); rope[pos * 32 + 16 + k] = __sinf(r); } }
    if (F.vcu < 32) { const int kind = F.vcu >> 4, kc = F.vcu & 15, n = F.tid & 127, kq = F.tid >> 7;
        const float* pe = A.in[kind ? 11 : 8]; const float* w1 = A.in[kind ? 12 : 9];
        float s = 0.f; const int kbeg = kc * 256 + kq * 64;
#pragma unroll 8
        for (int k = kbeg; k < kbeg + 64; ++k) s += pe[k] * w1[(size_t)k * 128 + n];
        ((float*)(ws + WS_CBPART))[(kind * 64 + kc * 4 + kq) * 128 + n] = s; }
    { bf16* WF = (bf16*)(ws + WS_WC1F);
      for (int i = gt; i < 2 * 8 * 16 * 4 * 2 * 64; i += NGT) {
          const int ln = i & 63, nt = (i >> 6) & 1, ks = (i >> 7) & 3, kt = (i >> 9) & 15, w = (i >> 13) & 7, kind = i >> 16;
          const int n = 32 * w + pg8::perm32(16 * nt + (ln & 15)), k = kt * 128 + 32 * ks + 8 * (ln >> 4);
          const float* src = A.in[kind ? 12 : 9] + (size_t)((n >> 7) * 2048 + k) * 128 + (n & 127);
          v4u o; o.x = cvtpk(src[0], src[128]); o.y = cvtpk(src[256], src[384]); o.z = cvtpk(src[512], src[640]); o.w = cvtpk(src[768], src[896]);
          *(v4u*)(WF + (size_t)i * 8) = o; } }
    { const f32x4* sp = (const f32x4*)A.in[4]; f32x4* po = (f32x4*)(F.out + O_POOLS);
      for (int i = gt; i < NS * 14 * 256; i += NGT) { const int s = i / (14 * 256), r = i % (14 * 256); po[s * 15 * 256 + r] = sp[s * 15 * 256 + 256 + r]; } }
}

using pg8::Unit;
using pg8::cvt_pk_bf16;
__device__ __forceinline__ f32x4 swap32(const f32x4 v, bool lower) {
    f32x4 o;
#pragma unroll
    for (int j = 0; j < 4; ++j) { const auto r = __builtin_amdgcn_permlane32_swap(__float_as_uint(v[j]), __float_as_uint(v[j]), false, false); o[j] = __uint_as_float(lower ? r[1] : r[0]); }
    return o;
}
struct EpiProj {
    static constexpr bool PERM = true, AFTER_DRAIN = false;
    unsigned char* ws; float* out; const float* rope;
    __device__ __forceinline__ void operator()(const f32x4 (&acc)[2][2][4][2], const Unit& u, int wr, int wc, int fr, int fq) const {
        const int pn = u.pn;
        const bool roped = ((pn < 4) || pn == 4 || pn == 6 || pn == 8) && wc == 0;
        const int d0 = wc * 32 + 8 * fq;
#pragma unroll
        for (int ai = 0; ai < 2; ++ai)
#pragma unroll
            for (int m = 0; m < 4; ++m) {
                asm volatile("" ::: "memory");
                const int row = u.pm * 256 + ai * 128 + wr * 64 + m * 16 + fr;
                if (row >= MTOK) continue;
                const bool prompt = row < NPTOK;
                const int b = row >> 11, t = row & 2047, s = row - NPTOK, pos = prompt ? t : PAST;
                f32x4 c0 = {1.f, 1.f, 1.f, 1.f}, c1 = c0, s0 = {0.f, 0.f, 0.f, 0.f}, s1 = s0;
                if (roped) { const float* rp = rope + pos * 32 + 8 * (fq & 1); c0 = *(const f32x4*)rp; c1 = *(const f32x4*)(rp + 4); s0 = *(const f32x4*)(rp + 16); s1 = *(const f32x4*)(rp + 20); }
#pragma unroll
                for (int bj = 0; bj < 2; ++bj) {
                    f32x4 v0 = acc[ai][bj][m][0], v1 = acc[ai][bj][m][1];
                    if (roped) { const f32x4 o0 = swap32(v0, fq < 2), o1 = swap32(v1, fq < 2);
                        if (fq < 2) { v0 = v0 * c0 - o0 * s0; v1 = v1 * c1 - o1 * s1; }
                        else        { v0 = o0 * s0 + v0 * c0; v1 = o1 * s1 + v1 * c1; } }
                    v4u pk; pk.x = cvtpk(v0[0], v0[1]); pk.y = cvtpk(v0[2], v0[3]); pk.z = cvtpk(v1[0], v1[1]); pk.w = cvtpk(v1[2], v1[3]);
                    if (pn < 4) {
                        *(v4u*)((bf16*)(ws + WS_Q) + (size_t)row * 1024 + pn * 256 + bj * 128 + d0) = pk;
                    } else if (pn < 8) {
                        float* o = out + (prompt ? O_KVP + (size_t)row * 1024 : O_KVS + (size_t)s * 1024) + (pn - 4) * 256 + bj * 128 + d0;
                        *(f32x4*)o = v0; *(f32x4*)(o + 4) = v1;
                        if (prompt) {
                            if (pn == 4 || pn == 5) *(v4u*)((bf16*)(ws + WS_KCP) + (size_t)(pn - 4) * (NB * NG * SEQ * 128) + ((size_t)(b * NG + bj) * SEQ + t) * 128 + d0) = pk;
                            else if (pn == 6) *(v4u*)((bf16*)(ws + WS_KS) + ((size_t)(b * NG + bj) * SEQ + t) * 128 + d0) = pk;
                            else { bf16* p = (bf16*)(ws + WS_VST) + ((size_t)(b * NG + bj) * 128 + d0) * SEQ + t;
                                p[0] = (bf16)(pk.x & 0xffffu); p[SEQ] = (bf16)(pk.x >> 16); p[2 * SEQ] = (bf16)(pk.y & 0xffffu); p[3 * SEQ] = (bf16)(pk.y >> 16);
                                p[4 * SEQ] = (bf16)(pk.z & 0xffffu); p[5 * SEQ] = (bf16)(pk.z >> 16); p[6 * SEQ] = (bf16)(pk.w & 0xffffu); p[7 * SEQ] = (bf16)(pk.w >> 16); }
                        }
                    } else if (pn < 10) {
                        const int kv = pn - 8;
                        if (prompt) {
                            if (t >= SEQ - WB) { float* o = out + O_WINP + ((size_t)(b * WB + (t - (SEQ - WB))) * 2 + kv) * 256 + bj * 128 + d0; *(f32x4*)o = v0; *(f32x4*)(o + 4) = v1; }
                            if (kv == 0) *(v4u*)((bf16*)(ws + WS_KW) + ((size_t)(b * NG + bj) * SEQ + t) * 128 + d0) = pk;
                            else { bf16* p = (bf16*)(ws + WS_VWT) + ((size_t)(b * NG + bj) * 128 + d0) * SEQ + t;
                                p[0] = (bf16)(pk.x & 0xffffu); p[SEQ] = (bf16)(pk.x >> 16); p[2 * SEQ] = (bf16)(pk.y & 0xffffu); p[3 * SEQ] = (bf16)(pk.y >> 16);
                                p[4 * SEQ] = (bf16)(pk.z & 0xffffu); p[5 * SEQ] = (bf16)(pk.z >> 16); p[6 * SEQ] = (bf16)(pk.w & 0xffffu); p[7 * SEQ] = (bf16)(pk.w >> 16); }
                        } else { float* o = out + O_WINS + ((size_t)(s * WB + (WB - 1)) * 2 + kv) * 256 + bj * 128 + d0; *(f32x4*)o = v0; *(f32x4*)(o + 4) = v1; }
                    } else if (pn < 14) {
                        const int cu = (pn - 10) * 256 + bj * 128 + d0;
                        *(v4u*)((bf16*)(ws + WS_U) + (size_t)row * 1024 + cu) = pk;
                        if (prompt) { if (t >= SEQ - 15) { float* o = out + O_POOLP + (size_t)(b * 15 + (t - (SEQ - 15))) * 1024 + cu; *(f32x4*)o = v0; *(f32x4*)(o + 4) = v1; } }
                        else { float* o = out + O_POOLS + (size_t)(s * 15 + 14) * 1024 + cu; *(f32x4*)o = v0; *(f32x4*)(o + 4) = v1; }
                    } else {
                        if (bj == 0 && wc == 0 && fq < 3) {
                            float* gp = (float*)(ws + WS_GATES) + (size_t)row * 24 + 8 * fq;
                            f32x4 g0, g1;
#pragma unroll
                            for (int j = 0; j < 4; ++j) { g0[j] = 1.f / (1.f + __expf(-v0[j])); g1[j] = 1.f / (1.f + __expf(-v1[j])); }
                            *(f32x4*)gp = g0; *(f32x4*)(gp + 4) = g1; }
                    }
                }
            }
    }
};
struct EpiCmpS {
    static constexpr bool PERM = true, AFTER_DRAIN = false;
    bf16* O;
    __device__ __forceinline__ void operator()(const f32x4 (&acc)[2][2][4][2], const Unit& u, int wr, int wc, int fr, int fq) const {
#pragma unroll
        for (int ai = 0; ai < 2; ++ai)
#pragma unroll
            for (int m = 0; m < 4; ++m) { const int row = u.pm * 256 + ai * 128 + wr * 64 + m * 16 + fr; bf16* rowp = O + (size_t)row * 256 + wc * 32 + 8 * fq;
#pragma unroll
                for (int bj = 0; bj < 2; ++bj) { const f32x4 v0 = acc[ai][bj][m][0], v1 = acc[ai][bj][m][1];
                    v4u w; w.x = cvtpk(v0[0], v0[1]); w.y = cvtpk(v0[2], v0[3]); w.z = cvtpk(v1[0], v1[1]); w.w = cvtpk(v1[2], v1[3]);
                    *(v4u*)(rowp + bj * 128) = w; } }
    }
};
struct CmpSOrder {
    int G, c;
    __device__ bool next(int i, Unit& u) const { const int L = i * G + c; if (L >= 256) return false; u.pm = L; u.pn = L >> 7; u.koff = 0; return true; }
    __device__ __forceinline__ void a_ready(const Unit&) const {}
    __device__ __forceinline__ void done(const Unit&) const {}
};
struct EpiCmpP {
    static constexpr bool PERM = false, AFTER_DRAIN = false;
    float* O;
    __device__ __forceinline__ void operator()(const f32x4 (&acc)[2][2][4][2], const Unit& u, int wr, int wc, int fr, int fq) const {
        float* base = O + (size_t)(u.koff >> 9) * (2048 * 256);
#pragma unroll
        for (int ai = 0; ai < 2; ++ai)
#pragma unroll
            for (int m = 0; m < 4; ++m) { const int row = u.pm * 256 + ai * 128 + wr * 64 + m * 16 + fr; float* rowp = base + (size_t)row * 256 + wc * 32 + 4 * fq;
#pragma unroll
                for (int bj = 0; bj < 2; ++bj)
#pragma unroll
                    for (int n = 0; n < 2; ++n) *(f32x4*)(rowp + bj * 128 + n * 16) = acc[ai][bj][m][n]; }
    }
};
struct CmpPOrder {
    int G, c;
    __device__ bool next(int i, Unit& u) const { const int L = i * G + c; if (c < 0 || L >= 32) return false; u.pm = L >> 2; u.pn = L >> 4; u.koff = (L & 3) * 512; return true; }
    __device__ __forceinline__ void a_ready(const Unit&) const {}
    __device__ __forceinline__ void done(const Unit&) const {}
};
struct EpiBf {
    static constexpr bool PERM = true, AFTER_DRAIN = false;
    bf16* C;
    __device__ __forceinline__ void operator()(const f32x4 (&acc)[2][2][4][2], const Unit& u, int wr, int wc, int fr, int fq) const {
#pragma unroll
        for (int ai = 0; ai < 2; ++ai)
#pragma unroll
            for (int m = 0; m < 4; ++m) { const int row = u.pm * 256 + ai * 128 + wr * 64 + m * 16 + fr; bf16* rowp = C + (size_t)row * DM + u.pn * 256 + wc * 32 + 8 * fq;
#pragma unroll
                for (int bj = 0; bj < 2; ++bj) { const f32x4 v0 = acc[ai][bj][m][0], v1 = acc[ai][bj][m][1];
                    v4u w; w.x = cvtpk(v0[0], v0[1]); w.y = cvtpk(v0[2], v0[3]); w.z = cvtpk(v1[0], v1[1]); w.w = cvtpk(v1[2], v1[3]);
                    *(v4u*)(rowp + bj * 128) = w; } }
    }
};
struct EpiUp {
    static constexpr bool PERM = true, AFTER_DRAIN = false;
    bf16* O;
    __device__ __forceinline__ void operator()(const f32x4 (&acc)[2][2][4][2], const Unit& u, int wr, int wc, int fr, int fq) const {
#pragma unroll
        for (int ai = 0; ai < 2; ++ai)
#pragma unroll
            for (int m = 0; m < 4; ++m) { const int row = u.pm * 256 + ai * 128 + wr * 64 + m * 16 + fr; bf16* rowp = O + (size_t)row * DFF + u.pn * 256 + wc * 32 + 8 * fq;
#pragma unroll
                for (int bj = 0; bj < 2; ++bj) { f32x4 v0 = acc[ai][bj][m][0], v1 = acc[ai][bj][m][1];
#pragma unroll
                    for (int j = 0; j < 4; ++j) { const float a = fmaxf(v0[j], 0.f), c = fmaxf(v1[j], 0.f); v0[j] = a * a; v1[j] = c * c; }
                    v4u w; w.x = cvtpk(v0[0], v0[1]); w.y = cvtpk(v0[2], v0[3]); w.z = cvtpk(v1[0], v1[1]); w.w = cvtpk(v1[2], v1[3]);
                    *(v4u*)(rowp + bj * 128) = w; } }
    }
};

struct RowExch { unsigned* xbuf; unsigned* cnt; unsigned* tmo; };
__device__ __forceinline__ void row_rstd(const RowExch& X, const f32x4 (&v)[2][2][4][2], const Unit& u, int wr, int wc, int fr, int fq, PG8_LAS unsigned char* lds, int wid, int lane) {
    PG8_LAS float* P = (PG8_LAS float*)lds;
    PG8_LAS float* S = (PG8_LAS float*)(lds + 4096);
#pragma unroll
    for (int ai = 0; ai < 2; ++ai)
#pragma unroll
        for (int m = 0; m < 4; ++m) { float q = 0.f;
#pragma unroll
            for (int bj = 0; bj < 2; ++bj)
#pragma unroll
                for (int n = 0; n < 2; ++n) { const f32x4 x = v[ai][bj][m][n]; q += (x[0] * x[0] + x[1] * x[1]) + (x[2] * x[2] + x[3] * x[3]); }
            q = xsum4(q);
            if (fq == 0) P[(ai * 128 + wr * 64 + m * 16 + fr) * 4 + wc] = q; }
    asm volatile("s_waitcnt lgkmcnt(0)" ::: "memory"); __builtin_amdgcn_s_barrier(); asm volatile("" ::: "memory");
    const int row = wid * 32 + (lane & 31);
    if (lane < 32) { const float tot = (P[row * 4 + 0] + P[row * 4 + 1]) + (P[row * 4 + 2] + P[row * 4 + 3]);
        __hip_atomic_store(X.xbuf + ((size_t)(u.pm * 256 + row) * 8 + u.pn), __float_as_uint(tot), __ATOMIC_RELAXED, __HIP_MEMORY_SCOPE_AGENT); }
    asm volatile("s_waitcnt vmcnt(0)" ::: "memory");
    if (lane == 0) __hip_atomic_fetch_add(X.cnt + 64 * u.pm, 1u, __ATOMIC_RELAXED, __HIP_MEMORY_SCOPE_AGENT);
    if (wid == 0) {
        const unsigned long long t0 = __builtin_amdgcn_s_memrealtime();
        for (;;) {
            if ((unsigned)__builtin_amdgcn_readfirstlane(__hip_atomic_load(X.cnt + 64 * u.pm, __ATOMIC_RELAXED, __HIP_MEMORY_SCOPE_AGENT)) >= 64u) break;
            if (__builtin_amdgcn_s_memrealtime() - t0 > 2000000ull) { if (lane == 0) __hip_atomic_store(X.tmo, 1u, __ATOMIC_RELAXED, __HIP_MEMORY_SCOPE_AGENT); break; }
            __builtin_amdgcn_s_sleep(2);
        }
        __builtin_amdgcn_fence(__ATOMIC_ACQUIRE, "agent");
    }
    asm volatile("s_waitcnt vmcnt(0) lgkmcnt(0)" ::: "memory"); __builtin_amdgcn_s_barrier(); asm volatile("" ::: "memory");
    if (lane < 32) { const unsigned* slot = X.xbuf + (size_t)(u.pm * 256 + row) * 8; float t = 0.f;
#pragma unroll
        for (int k = 0; k < 8; ++k) t += __uint_as_float(__hip_atomic_load(slot + k, __ATOMIC_RELAXED, __HIP_MEMORY_SCOPE_AGENT));
        S[row] = 1.f / sqrtf(t * (1.f / DM) + EPS); }
    asm volatile("s_waitcnt lgkmcnt(0)" ::: "memory"); __builtin_amdgcn_s_barrier(); asm volatile("" ::: "memory");
}
struct EpiWoFused {
    static constexpr bool PERM = false, AFTER_DRAIN = true;
    const float* x; const float* gpost; float* out; bf16* xn; RowExch X1, X2;
    __device__ __forceinline__ void operator()(const f32x4 (&)[2][2][4][2], const Unit&, int, int, int, int) const {}
    __device__ __forceinline__ void fused(f32x4 (&acc)[2][2][4][2], const Unit& u, int wr, int wc, int fr, int fq, PG8_LAS unsigned char* lds, int wid, int lane) const {
        const PG8_LAS float* S = (const PG8_LAS float*)(lds + 4096);
        row_rstd(X1, acc, u, wr, wc, fr, fq, lds, wid, lane);
        const int col0 = u.pn * 256 + wc * 32 + 4 * fq;
#pragma unroll
        for (int ai = 0; ai < 2; ++ai)
#pragma unroll
            for (int m = 0; m < 4; ++m) { const int r = ai * 128 + wr * 64 + m * 16 + fr; const float r1 = S[r]; const size_t off = (size_t)(u.pm * 256 + r) * DM + col0;
#pragma unroll
                for (int bj = 0; bj < 2; ++bj)
#pragma unroll
                    for (int n = 0; n < 2; ++n) { const f32x4 xv = *(const f32x4*)(x + off + bj * 128 + n * 16), gv = *(const f32x4*)(gpost + col0 + bj * 128 + n * 16);
                        const f32x4 y = xv + acc[ai][bj][m][n] * gv * r1; acc[ai][bj][m][n] = y; *(f32x4*)(out + off + bj * 128 + n * 16) = y; }
                asm volatile("" : "+v"(acc[ai][0][m][0]), "+v"(acc[ai][0][m][1]), "+v"(acc[ai][1][m][0]), "+v"(acc[ai][1][m][1]));
                asm volatile("" ::: "memory"); }
        row_rstd(X2, acc, u, wr, wc, fr, fq, lds, wid, lane);
#pragma unroll
        for (int ai = 0; ai < 2; ++ai)
#pragma unroll
            for (int m = 0; m < 4; ++m) { const int r = ai * 128 + wr * 64 + m * 16 + fr; const float r2 = S[r]; const size_t off = (size_t)(u.pm * 256 + r) * DM + col0;
#pragma unroll
                for (int bj = 0; bj < 2; ++bj)
#pragma unroll
                    for (int n = 0; n < 2; ++n) { const f32x4 y = acc[ai][bj][m][n] * r2; u32x2v w; w.x = cvtpk(y[0], y[1]); w.y = cvtpk(y[2], y[3]); *(u32x2v*)(xn + off + bj * 128 + n * 16) = w; } }
    }
};
struct EpiDownFused {
    static constexpr bool PERM = false, AFTER_DRAIN = true;
    const float* gpost; float* out; RowExch X;
    __device__ __forceinline__ void operator()(const f32x4 (&)[2][2][4][2], const Unit&, int, int, int, int) const {}
    __device__ __forceinline__ void fused(f32x4 (&acc)[2][2][4][2], const Unit& u, int wr, int wc, int fr, int fq, PG8_LAS unsigned char* lds, int wid, int lane) const {
        const PG8_LAS float* S = (const PG8_LAS float*)(lds + 4096);
        row_rstd(X, acc, u, wr, wc, fr, fq, lds, wid, lane);
        const int col0 = u.pn * 256 + wc * 32 + 4 * fq;
#pragma unroll
        for (int ai = 0; ai < 2; ++ai)
#pragma unroll
            for (int m = 0; m < 4; ++m) { const int r = ai * 128 + wr * 64 + m * 16 + fr; const float rs = S[r]; const size_t off = (size_t)(u.pm * 256 + r) * DM + col0;
#pragma unroll
                for (int bj = 0; bj < 2; ++bj)
#pragma unroll
                    for (int n = 0; n < 2; ++n) { const f32x4 yv = *(const f32x4*)(out + off + bj * 128 + n * 16), gv = *(const f32x4*)(gpost + col0 + bj * 128 + n * 16);
                        *(f32x4*)(out + off + bj * 128 + n * 16) = yv + acc[ai][bj][m][n] * gv * rs; }
                asm volatile("" ::: "memory"); }
    }
};

typedef short s16x4 __attribute__((ext_vector_type(4)));
__device__ __forceinline__ f32x4 mfma16(bf16x8 a, bf16x8 b, f32x4 c) { return __builtin_amdgcn_mfma_f32_16x16x32_bf16(a, b, c, 0, 0, 0); }

constexpr int PL_ROW = 528;
template <int W>
__device__ __forceinline__ void pool_dtile(Frame& F, const Args& A, LAS unsigned char* dl, int tid, int row0, int g) {
    const bf16* U = (const bf16*)(F.ws + WS_U);
    const int c = tid & 255, half = tid >> 8, rfirst = row0 + half * 32;
    const bf16* ucol = U + g * 256 + c;
    if (row0 < NPTOK) {
        const int tfirst = rfirst & 2047;
        float uv[32 + W - 1];
        unsigned short raw[32 + W - 1];
#pragma unroll
        for (int i = 0; i < 32 + W - 1; ++i) { const int t = tfirst - (W - 1) + i; const int tc = t < 0 ? 0 : t; raw[i] = ucol[(size_t)(rfirst - tfirst + tc) * 1024]; }
#pragma unroll
        for (int i = 0; i < 32 + W - 1; ++i) { const int t = tfirst - (W - 1) + i; uv[i] = (t >= 0) ? bf2f(raw[i]) : 0.f; }
        float sum = 0.f;
#pragma unroll
        for (int j = 0; j < W - 1; ++j) sum += uv[j];
#pragma unroll
        for (int i = 0; i < 32; ++i) { const int t = tfirst + i; const float cur = uv[W - 1 + i]; sum += cur;
            const int cnt = (t + 1 < W) ? (t + 1) : W;
            const float d = sum / (float)cnt - cur;
            *(LAS bf16*)(dl + (half * 32 + i) * PL_ROW + c * 2) = (bf16)(cvtpk(d, 0.f) & 0xffffu);
            sum -= uv[i]; }
    } else {
        const float* spool = A.in[4];
#pragma unroll 1
        for (int i0 = 0; i0 < 32; i0 += 4) {
            float v[4][W - 1]; unsigned short cu[4];
#pragma unroll
            for (int u = 0; u < 4; ++u) { const int s = rfirst - NPTOK + i0 + u; cu[u] = ucol[(size_t)(NPTOK + s) * 1024];
#pragma unroll
                for (int j = 0; j < W - 1; ++j) v[u][j] = spool[((size_t)s * 15 + 14 - j) * 1024 + g * 256 + c]; }
#pragma unroll
            for (int u = 0; u < 4; ++u) { const float cur = bf2f(cu[u]); float sum = cur;
#pragma unroll
                for (int j = 0; j < W - 1; ++j) sum += v[u][j];
                const float d = sum / (float)W - cur;
                *(LAS bf16*)(dl + (half * 32 + i0 + u) * PL_ROW + c * 2) = (bf16)(cvtpk(d, 0.f) & 0xffffu); }
        }
    }
}
__device__ __forceinline__ void pool_phase(Frame& F, const Args& A, unsigned* qword) {
    LAS unsigned char* dl = F.lds + RING_OFF;
    const bf16* PW = (const bf16*)(F.ws + WS_POOLW_T); bf16* CC = (bf16*)(F.ws + WS_CONCAT);
    const float* pscale = A.in[15];
    const int tid_ = fresh_tid(F);
    const int lane = tid_ & 63, idx = lane & 15, q = lane >> 4;
    for (;;) {
        if (F.tid == 0) F.MISC[1] = __hip_atomic_fetch_add(qword, 1u, __ATOMIC_RELAXED, __HIP_MEMORY_SCOPE_AGENT);
        __syncthreads();
        const int item = __builtin_amdgcn_readfirstlane((int)F.MISC[1]);
        __syncthreads();
        if (item >= 130 * 4) break;
        const int unit = item < 8 ? 512 + item : item - 8;
        const int tt = unit >> 2, g = unit & 3, w = 2 << g, row0 = tt * 64;
        bf16x8 wf[2][8];
        { const bf16* pwb = PW + ((size_t)g * 256 + 32 * F.wave + idx) * 256 + 8 * q;
#pragma unroll
          for (int nt = 0; nt < 2; ++nt)
#pragma unroll
              for (int ks = 0; ks < 8; ++ks) wf[nt][ks] = *(const bf16x8*)(pwb + (size_t)(16 * nt) * 256 + 32 * ks); }
        if (g == 0) pool_dtile<2>(F, A, dl, tid_, row0, g); else if (g == 1) pool_dtile<4>(F, A, dl, tid_, row0, g); else if (g == 2) pool_dtile<8>(F, A, dl, tid_, row0, g); else pool_dtile<16>(F, A, dl, tid_, row0, g);
        __syncthreads();
        {
            const int w8 = F.wave;
            f32x4 acc[4][2];
#pragma unroll
            for (int mt = 0; mt < 4; ++mt) { acc[mt][0] = (f32x4){0.f, 0.f, 0.f, 0.f}; acc[mt][1] = (f32x4){0.f, 0.f, 0.f, 0.f}; }
#pragma unroll
            for (int ks = 0; ks < 8; ++ks) {
                bf16x8 df[4];
#pragma unroll
                for (int mt = 0; mt < 4; ++mt) df[mt] = *(const LAS bf16x8*)(dl + (16 * mt + idx) * PL_ROW + (32 * ks + 8 * q) * 2);
#pragma unroll
                for (int mt = 0; mt < 4; ++mt) { acc[mt][0] = mfma16(wf[0][ks], df[mt], acc[mt][0]); acc[mt][1] = mfma16(wf[1][ks], df[mt], acc[mt][1]); }
            }
#pragma unroll
            for (int nt = 0; nt < 2; ++nt) { const int e = 32 * w8 + 16 * nt + 4 * q; const f32x4 sc = *(const f32x4*)(pscale + g * 256 + e);
#pragma unroll
                for (int mt = 0; mt < 4; ++mt) { const int row = row0 + 16 * mt + idx;
                    if (row < MTOK) { u32x2v o; o.x = cvtpk(acc[mt][nt][0] * sc[0], acc[mt][nt][1] * sc[1]); o.y = cvtpk(acc[mt][nt][2] * sc[2], acc[mt][nt][3] * sc[3]);
                        *(u32x2v*)(CC + (size_t)row * DM + 1024 + g * 256 + e) = o; } } }
        }
        __syncthreads();
    }
}

__device__ __forceinline__ float gelu_tanh(float x) {
    const float u = 0.7978845608028654f * (x + 0.044715f * x * x * x);
    const float e = __expf(2.f * u);
    const float th = 1.f - 2.f / (e + 1.f);
    return 0.5f * x * (1.f + th);
}
__device__ __forceinline__ void cmp2_phase(Frame& F, int lo, int hi) {
    const int tid_ = fresh_tid(F);
    const int lane = tid_ & 63, idx = lane & 15, q = lane >> 4, w = F.wave;
    const float* cb = (const float*)(F.ws + WS_CBIAS);
    LAS unsigned char* wl = F.lds + RING_OFF;
    { const v4u* src = (const v4u*)(F.ws + WS_WC2_T);
#pragma unroll
      for (int j = 0; j < 8; ++j) { const int cidx = tid_ + 512 * j; *(LAS v4u*)(wl + (cidx >> 4) * 272 + (cidx & 15) * 16) = src[cidx]; } }
    __syncthreads();
    for (int unit = lo + F.vcu; unit < hi; unit += F.G) {
        const bool smp = unit < 512; const int uu = smp ? unit : unit - 512; const int sg = uu >> 1, kind = uu & 1;
        const int i = 16 * w + idx;
        bf16x8 gf[4];
        if (smp) {
            const bf16* TB = (const bf16*)(F.ws + WS_TBS) + ((size_t)kind * 32768 + (size_t)sg * 128) * 256;
#pragma unroll
            for (int ks = 0; ks < 4; ++ks) { const int k = 32 * ks + 8 * q;
                const int ic = (i < NCMP) ? i : 0;
                const v4u tv = *(const v4u*)(TB + (size_t)ic * 256 + k), bv = *(const v4u*)(TB + (size_t)(ic + 1) * 256 + 128 + k);
                const f32x4 c0 = *(const f32x4*)(cb + kind * 128 + k), c1 = *(const f32x4*)(cb + kind * 128 + k + 4);
                float h[8];
                h[0] = bf_lo(tv.x) + bf_lo(bv.x) + c0[0]; h[1] = bf_hi(tv.x) + bf_hi(bv.x) + c0[1]; h[2] = bf_lo(tv.y) + bf_lo(bv.y) + c0[2]; h[3] = bf_hi(tv.y) + bf_hi(bv.y) + c0[3];
                h[4] = bf_lo(tv.z) + bf_lo(bv.z) + c1[0]; h[5] = bf_hi(tv.z) + bf_hi(bv.z) + c1[1]; h[6] = bf_lo(tv.w) + bf_lo(bv.w) + c1[2]; h[7] = bf_hi(tv.w) + bf_hi(bv.w) + c1[3];
#pragma unroll
                for (int e = 0; e < 8; ++e) h[e] = (i < NCMP) ? gelu_tanh(h[e]) : 0.f;
                v4u o; o.x = cvtpk(h[0], h[1]); o.y = cvtpk(h[2], h[3]); o.z = cvtpk(h[4], h[5]); o.w = cvtpk(h[6], h[7]);
                gf[ks] = __builtin_bit_cast(bf16x8, o); }
        } else {
            const float* TB = (const float*)(F.ws + WS_TBP) + ((size_t)kind * 1024 + (size_t)sg * 128) * 256;
#pragma unroll
            for (int ks = 0; ks < 4; ++ks) { const int k = 32 * ks + 8 * q;
                f32x4 t0 = {0.f, 0.f, 0.f, 0.f}, t1 = t0, b0 = t0, b1 = t0;
                {
                    const int ic = (i < NCMP) ? i : 0;
                    f32x4 pv[4][4];
#pragma unroll
                    for (int sl = 0; sl < 4; ++sl) { const float* T8 = TB + (size_t)sl * (2048 * 256);
                        pv[sl][0] = *(const f32x4*)(T8 + (size_t)ic * 256 + k); pv[sl][1] = *(const f32x4*)(T8 + (size_t)ic * 256 + k + 4);
                        pv[sl][2] = *(const f32x4*)(T8 + (size_t)(ic + 1) * 256 + 128 + k); pv[sl][3] = *(const f32x4*)(T8 + (size_t)(ic + 1) * 256 + 128 + k + 4); }
#pragma unroll
                    for (int sl = 0; sl < 4; ++sl) { t0 = t0 + pv[sl][0]; t1 = t1 + pv[sl][1]; b0 = b0 + pv[sl][2]; b1 = b1 + pv[sl][3]; }
                }
                const f32x4 c0 = *(const f32x4*)(cb + kind * 128 + k), c1 = *(const f32x4*)(cb + kind * 128 + k + 4);
                float h[8];
#pragma unroll
                for (int e = 0; e < 4; ++e) { h[e] = t0[e] + b0[e] + c0[e]; h[4 + e] = t1[e] + b1[e] + c1[e]; }
#pragma unroll
                for (int e = 0; e < 8; ++e) h[e] = (i < NCMP) ? gelu_tanh(h[e]) : 0.f;
                v4u o; o.x = cvtpk(h[0], h[1]); o.y = cvtpk(h[2], h[3]); o.z = cvtpk(h[4], h[5]); o.w = cvtpk(h[6], h[7]);
                gf[ks] = __builtin_bit_cast(bf16x8, o); }
        }
        const LAS unsigned char* W2 = wl + kind * (128 * 272) + idx * 272 + q * 16;
        const bool transposed = (!smp) && kind == 1;
        bf16* outp = smp ? (bf16*)(F.ws + WS_CMPS) + ((size_t)sg * 2 + kind) * 16384 : (bf16*)(F.ws + WS_CMPP) + ((size_t)sg * 2 + kind) * 16384;
#pragma unroll
        for (int nt = 0; nt < 8; ++nt) {
            f32x4 acc = {0.f, 0.f, 0.f, 0.f};
            if (!transposed) {
#pragma unroll
                for (int ks = 0; ks < 4; ++ks) { const bf16x8 wf = *(const LAS bf16x8*)(W2 + nt * (16 * 272) + ks * 64); acc = mfma16(wf, gf[ks], acc); }
                u32x2v o; o.x = cvtpk(acc[0], acc[1]); o.y = cvtpk(acc[2], acc[3]);
                *(u32x2v*)(outp + (size_t)i * 128 + 16 * nt + 4 * q) = o;
            } else {
#pragma unroll
                for (int ks = 0; ks < 4; ++ks) { const bf16x8 wf = *(const LAS bf16x8*)(W2 + nt * (16 * 272) + ks * 64); acc = mfma16(gf[ks], wf, acc); }
                u32x2v o; o.x = cvtpk(acc[0], acc[1]); o.y = cvtpk(acc[2], acc[3]);
                *(u32x2v*)(outp + (size_t)(16 * nt + idx) * 128 + 16 * w + 4 * q) = o;
            }
        }
    }
    __syncthreads();
}

template <int NT, int CH, class EpiS>
__device__ __forceinline__ void skinny_gemm(Frame& F, const bf16* A, const bf16* Bt, int K, int N, const EpiS& E) {
    const int tid_ = fresh_tid(F);
    const int lane = tid_ & 63, idx = lane & 15, q = lane >> 4, w = F.wave;
    LAS f32x4* RED = (LAS f32x4*)(F.lds + RING_OFF);
    static_assert(8 * 4 * NT * 64 * 16 <= RING_BYTES, "skinny reduction LDS");
    const int npieces = (N / (16 * NT)) * 2, kw = K / 8, nks = kw / 32;
    for (int piece = F.vcu; piece < npieces; piece += F.G) {
        const int rh = piece & 1, cg = piece >> 1;
        const bf16* ap = A + (size_t)(64 * rh + idx) * K + w * kw + 8 * q;
        const bf16* bp = Bt + (size_t)(16 * NT * cg + idx) * K + w * kw + 8 * q;
        f32x4 acc[NT][4];
#pragma unroll
        for (int nt = 0; nt < NT; ++nt)
#pragma unroll
            for (int mt = 0; mt < 4; ++mt) acc[nt][mt] = (f32x4){0.f, 0.f, 0.f, 0.f};
#pragma unroll 1
        for (int k0 = 0; k0 < nks; k0 += CH) {
            bf16x8 bf[CH][NT], af[CH][4];
#pragma unroll
            for (int j = 0; j < CH; ++j) {
#pragma unroll
                for (int nt = 0; nt < NT; ++nt) bf[j][nt] = *(const bf16x8*)(bp + (size_t)(16 * nt) * K + 32 * (k0 + j));
#pragma unroll
                for (int mt = 0; mt < 4; ++mt) af[j][mt] = *(const bf16x8*)(ap + (size_t)(16 * mt) * K + 32 * (k0 + j)); }
#pragma unroll
            for (int j = 0; j < CH; ++j)
#pragma unroll
                for (int nt = 0; nt < NT; ++nt)
#pragma unroll
                    for (int mt = 0; mt < 4; ++mt) acc[nt][mt] = mfma16(bf[j][nt], af[j][mt], acc[nt][mt]);
        }
#pragma unroll
        for (int nt = 0; nt < NT; ++nt)
#pragma unroll
            for (int mt = 0; mt < 4; ++mt) RED[(w * (4 * NT) + nt * 4 + mt) * 64 + lane] = acc[nt][mt];
        __syncthreads();
        for (int t = w; t < 4 * NT; t += 8) { f32x4 v = RED[t * 64 + lane];
#pragma unroll
            for (int ww = 1; ww < 8; ++ww) v = v + RED[(ww * (4 * NT) + t) * 64 + lane];
            E(64 * rh + 16 * (t & 3) + idx, 16 * (NT * cg + (t >> 2)) + 4 * q, v); }
        __syncthreads();
    }
}
struct SkBf { bf16* C; int ld; __device__ __forceinline__ void operator()(int row, int col, f32x4 v) const { u32x2v o; o.x = cvtpk(v[0], v[1]); o.y = cvtpk(v[2], v[3]); *(u32x2v*)(C + (size_t)row * ld + col) = o; } };
struct SkUp { bf16* O; __device__ __forceinline__ void operator()(int row, int col, f32x4 v) const {
    float a[4];
#pragma unroll
    for (int j = 0; j < 4; ++j) { const float t = fmaxf(v[j], 0.f); a[j] = t * t; }
    u32x2v o; o.x = cvtpk(a[0], a[1]); o.y = cvtpk(a[2], a[3]); *(u32x2v*)(O + (size_t)row * DFF + col) = o; } };

__device__ __forceinline__ void unpack8(float (&f)[8], const v4u t) { f[0] = bf_lo(t.x); f[1] = bf_hi(t.x); f[2] = bf_lo(t.y); f[3] = bf_hi(t.y); f[4] = bf_lo(t.z); f[5] = bf_hi(t.z); f[6] = bf_lo(t.w); f[7] = bf_hi(t.w); }
__device__ __forceinline__ void p5_rows(Frame& F, const Args& A, int mlo) {
    const int lane_ = fresh_tid(F) & 63;
    const int gw = F.vcu * NWAVES + F.wave, NGW = F.G * NWAVES;
    const bf16* Mb = (const bf16*)(F.ws + WS_M); const float* gpost = A.in[17];
    for (int m = mlo + gw; m < MTOK; m += NGW) {
        const float* xrow = (m < NPTOK) ? A.in[0] + (size_t)m * DM : A.in[1] + (size_t)(m - NPTOK) * DM;
        float v[4][8]; f32x4 xa[4], xb[4]; float s1 = 0.f;
#pragma unroll
        for (int j = 0; j < 4; ++j) { const int col = 512 * j + 8 * lane_; unpack8(v[j], __builtin_nontemporal_load((const v4u*)(Mb + (size_t)m * DM + col))); xa[j] = __builtin_nontemporal_load((const f32x4*)(xrow + col)); xb[j] = __builtin_nontemporal_load((const f32x4*)(xrow + col + 4)); }
#pragma unroll
        for (int j = 0; j < 4; ++j)
#pragma unroll
            for (int e = 0; e < 8; ++e) s1 += v[j][e] * v[j][e];
        const float r1 = 1.f / sqrtf(wave_sum(s1) * (1.f / DM) + EPS);
        float s = 0.f;
#pragma unroll
        for (int j = 0; j < 4; ++j) { const int col = 512 * j + 8 * lane_; const f32x4 ga = *(const f32x4*)(gpost + col), gb = *(const f32x4*)(gpost + col + 4);
#pragma unroll
            for (int e = 0; e < 4; ++e) { v[j][e] = xa[j][e] + v[j][e] * ga[e] * r1; v[j][4 + e] = xb[j][e] + v[j][4 + e] * gb[e] * r1; }
#pragma unroll
            for (int e = 0; e < 8; ++e) s += v[j][e] * v[j][e]; }
        const float r2 = 1.f / sqrtf(wave_sum(s) * (1.f / DM) + EPS);
#pragma unroll
        for (int j = 0; j < 4; ++j) { const int col = 512 * j + 8 * lane_;
            v4u w; w.x = cvtpk(v[j][0] * r2, v[j][1] * r2); w.y = cvtpk(v[j][2] * r2, v[j][3] * r2); w.z = cvtpk(v[j][4] * r2, v[j][5] * r2); w.w = cvtpk(v[j][6] * r2, v[j][7] * r2);
            *(v4u*)((bf16*)(F.ws + WS_XN) + (size_t)m * DM + col) = w; }
    }
}
__device__ __forceinline__ void p8_rows(Frame& F, const Args& A, int mlo) {
    const int lane_ = fresh_tid(F) & 63;
    const int gw = F.vcu * NWAVES + F.wave, NGW = F.G * NWAVES;
    const bf16* M1 = (const bf16*)(F.ws + WS_M); const bf16* M2 = (const bf16*)(F.ws + WS_M2); const float* g1 = A.in[17]; const float* g2 = A.in[21];
    for (int m = mlo + gw; m < MTOK; m += NGW) {
        const float* xrow = (m < NPTOK) ? A.in[0] + (size_t)m * DM : A.in[1] + (size_t)(m - NPTOK) * DM;
        float* orow = F.out + ((m < NPTOK) ? O_YP + (size_t)m * DM : O_YS + (size_t)(m - NPTOK) * DM);
        float v[4][8], u[4][8]; f32x4 xa[4], xb[4]; float s1 = 0.f, s2 = 0.f;
#pragma unroll
        for (int j = 0; j < 4; ++j) { const int col = 512 * j + 8 * lane_; unpack8(v[j], __builtin_nontemporal_load((const v4u*)(M1 + (size_t)m * DM + col))); unpack8(u[j], __builtin_nontemporal_load((const v4u*)(M2 + (size_t)m * DM + col)));
            xa[j] = __builtin_nontemporal_load((const f32x4*)(xrow + col)); xb[j] = __builtin_nontemporal_load((const f32x4*)(xrow + col + 4)); }
#pragma unroll
        for (int j = 0; j < 4; ++j)
#pragma unroll
            for (int e = 0; e < 8; ++e) { s1 += v[j][e] * v[j][e]; s2 += u[j][e] * u[j][e]; }
        const float r1 = 1.f / sqrtf(wave_sum(s1) * (1.f / DM) + EPS);
        const float r2 = 1.f / sqrtf(wave_sum(s2) * (1.f / DM) + EPS);
#pragma unroll
        for (int j = 0; j < 4; ++j) { const int col = 512 * j + 8 * lane_;
            const f32x4 ga = *(const f32x4*)(g1 + col), gb = *(const f32x4*)(g1 + col + 4), ha = *(const f32x4*)(g2 + col), hb = *(const f32x4*)(g2 + col + 4);
            f32x4 oa, ob;
#pragma unroll
            for (int e = 0; e < 4; ++e) { const float ya = xa[j][e] + v[j][e] * ga[e] * r1, yb = xb[j][e] + v[j][4 + e] * gb[e] * r1;
                oa[e] = ya + u[j][e] * ha[e] * r2; ob[e] = yb + u[j][4 + e] * hb[e] * r2; }
            *(f32x4*)(orow + col) = oa; *(f32x4*)(orow + col + 4) = ob; }
    }
}

constexpr int CF_ROW = 272, CF_BUF = 128 * CF_ROW;
#define CF_BAR() do { asm volatile("s_waitcnt lgkmcnt(0)" ::: "memory"); __builtin_amdgcn_s_barrier(); asm volatile("" ::: "memory"); } while (0)
#define CF_LOAD(S, kt_) do { _Pragma("unroll") for (int j = 0; j < 8; ++j) S[j] = __builtin_nontemporal_load((const f32x4*)(cbase + (size_t)(PTL[j] + rowc + (unsigned)(kt_) * 4096u))); } while (0)
#define CF_WRITE(S, bufoff) do { _Pragma("unroll") for (int j = 0; j < 8; ++j) { u32x2v o; o.x = cvtpk(S[j].x, S[j].y); o.y = cvtpk(S[j].z, S[j].w); *(LAS u32x2v*)(wr_ + (bufoff) + j * 8 * CF_ROW) = o; } } while (0)
#define CF_LOADB(BX, kt_) do { _Pragma("unroll") for (int ks = 0; ks < 4; ++ks) { BX[0][ks] = *(const bf16x8*)(bp + (size_t)(((kt_) * 4 + ks) * 2 + 0) * 512); BX[1][ks] = *(const bf16x8*)(bp + (size_t)(((kt_) * 4 + ks) * 2 + 1) * 512); } } while (0)
#define CF_MMA(bufoff, BX) do { _Pragma("unroll") for (int ks = 0; ks < 4; ++ks) { _Pragma("unroll") for (int mh = 0; mh < 2; ++mh) { bf16x8 af[4]; \
        _Pragma("unroll") for (int m4 = 0; m4 < 4; ++m4) af[m4] = *(const LAS bf16x8*)(rd_ + (bufoff) + (4 * mh + m4) * 16 * CF_ROW + ks * 64); \
        __builtin_amdgcn_sched_barrier(0); \
        _Pragma("unroll") for (int m4 = 0; m4 < 4; ++m4) { acc[4 * mh + m4][0] = mfma16(BX[0][ks], af[m4], acc[4 * mh + m4][0]); acc[4 * mh + m4][1] = mfma16(BX[1][ks], af[m4], acc[4 * mh + m4][1]); } \
        __builtin_amdgcn_sched_barrier(0); } } } while (0)
__device__ __forceinline__ void cmps_fused_phase(Frame& F, const Args& A, int ufirst, int ustride) {
    const int tid_ = fresh_tid(F);
    const int lane = tid_ & 63, idx = lane & 15, q = lane >> 4, w = F.wave;
    const int lw = tid_ >> 6, lg = (tid_ >> 5) & 1, lcol = tid_ & 31;
    const int* pt = (const int*)A.in[5]; const float* cache = A.in[2];
    LAS unsigned char* L = F.lds + RING_OFF;
    LAS unsigned char* wr_ = L + (lg * 64 + lw) * CF_ROW + lcol * 8;
    const LAS unsigned char* rd_ = L + idx * CF_ROW + q * 16;
    int zero_ = 0; asm volatile("" : "+v"(zero_));
    volatile LAS unsigned* PTL = (volatile LAS unsigned*)(L + 2 * CF_BUF + zero_);
    const unsigned rowc = (unsigned)(16 * lw) * 4096u + lg * 512u + lcol * 16;
    for (int unit = ufirst; unit < 512; unit += ustride) {
        const int kind = unit & 1, ch = (unit >> 1) & 1, s = unit >> 2;
        const char* cbase = (const char*)cache + (size_t)(kind * 256) * 4;
        if (tid_ < 8) PTL[tid_] = (unsigned)pt[s * NPAGES + 8 * ch + tid_] * (PAGE * 4096u);
        __syncthreads();
        const bf16* bp = (const bf16*)(F.ws + WS_WC1F) + (size_t)(kind * 8 + w) * (16 * 4 * 2 * 512) + lane * 8;
        f32x4 acc[8][2];
#pragma unroll
        for (int mt = 0; mt < 8; ++mt) { acc[mt][0] = (f32x4){0.f, 0.f, 0.f, 0.f}; acc[mt][1] = (f32x4){0.f, 0.f, 0.f, 0.f}; }
        f32x4 s0[8], s1[8]; bf16x8 b0[2][4], b1[2][4];
        CF_LOADB(b0, 0); CF_LOAD(s0, 0); CF_LOAD(s1, 1);
        CF_WRITE(s0, 0);
        CF_BAR();
#pragma unroll 1
        for (int kt = 0; kt < 16; kt += 2) {
            CF_LOADB(b1, kt + 1); if (kt + 2 < 16) CF_LOAD(s0, kt + 2);
            CF_MMA(0, b0);
            CF_WRITE(s1, CF_BUF);
            CF_BAR();
            if (kt + 2 < 16) CF_LOADB(b0, kt + 2); if (kt + 3 < 16) CF_LOAD(s1, kt + 3);
            CF_MMA(CF_BUF, b1);
            if (kt + 2 < 16) CF_WRITE(s0, 0);
            CF_BAR();
        }
        bf16* op = (bf16*)(F.ws + WS_TBS) + ((size_t)kind * 32768 + (size_t)(s * 2) * 128 + 64 * ch + idx) * 256 + 32 * w + 8 * q;
#pragma unroll
        for (int mt = 0; mt < 8; ++mt) {
            v4u o; o.x = cvtpk(acc[mt][0][0], acc[mt][0][1]); o.y = cvtpk(acc[mt][0][2], acc[mt][0][3]); o.z = cvtpk(acc[mt][1][0], acc[mt][1][1]); o.w = cvtpk(acc[mt][1][2], acc[mt][1][3]);
            *(v4u*)(op + (size_t)((mt >> 2) * 128 + 16 * (mt & 3)) * 256) = o; }
    }
}

constexpr int CP_TB = 2 * CF_BUF + 64, CP_TBROW = 528;
#define CP_LOAD(S, kt_) do { _Pragma("unroll") for (int j = 0; j < 4; ++j) { const int p_ = tid_ + 512 * j; S[j] = *(const v4u*)(Ak + ((size_t)(16 * (p_ >> 4) + (kt_))) * 128 + (p_ & 15) * 8); } } while (0)
#define CP_WRITE(S, bufoff) do { _Pragma("unroll") for (int j = 0; j < 4; ++j) { const int p_ = tid_ + 512 * j; *(LAS v4u*)(L + (bufoff) + (p_ >> 4) * CF_ROW + (p_ & 15) * 16) = S[j]; } } while (0)
__device__ __forceinline__ void cmpp_fused_unit(Frame& F, int bg, int kind) {
    const int tid_ = fresh_tid(F);
    const int lane = tid_ & 63, idx = lane & 15, q = lane >> 4, w = F.wave;
    LAS unsigned char* L = F.lds + RING_OFF;
    const LAS unsigned char* rd_ = L + idx * CF_ROW + q * 16;
    const bf16* Ak = (const bf16*)(F.ws + WS_KCP) + (size_t)kind * (NB * NG * SEQ * 128) + (size_t)bg * SEQ * 128;
    const bf16* bp = (const bf16*)(F.ws + WS_WC1F) + (size_t)(kind * 8 + w) * (16 * 4 * 2 * 512) + lane * 8;
    f32x4 acc[8][2];
#pragma unroll
    for (int mt = 0; mt < 8; ++mt) { acc[mt][0] = (f32x4){0.f, 0.f, 0.f, 0.f}; acc[mt][1] = (f32x4){0.f, 0.f, 0.f, 0.f}; }
    v4u s0[4], s1[4]; bf16x8 b0[2][4], b1[2][4];
    CF_LOADB(b0, 0); CP_LOAD(s0, 0); CP_LOAD(s1, 1);
    CP_WRITE(s0, 0);
    CF_BAR();
#pragma unroll 1
    for (int kt = 0; kt < 16; kt += 2) {
        CF_LOADB(b1, kt + 1); if (kt + 2 < 16) CP_LOAD(s0, kt + 2);
        CF_MMA(0, b0);
        CP_WRITE(s1, CF_BUF);
        CF_BAR();
        if (kt + 2 < 16) CF_LOADB(b0, kt + 2); if (kt + 3 < 16) CP_LOAD(s1, kt + 3);
        CF_MMA(CF_BUF, b1);
        if (kt + 2 < 16) CP_WRITE(s0, 0);
        CF_BAR();
    }
#pragma unroll
    for (int mt = 0; mt < 8; ++mt) { v4u o; o.x = cvtpk(acc[mt][0][0], acc[mt][0][1]); o.y = cvtpk(acc[mt][0][2], acc[mt][0][3]); o.z = cvtpk(acc[mt][1][0], acc[mt][1][1]); o.w = cvtpk(acc[mt][1][2], acc[mt][1][3]);
        *(LAS v4u*)(L + CP_TB + (16 * mt + idx) * CP_TBROW + (32 * w + 8 * q) * 2) = o; }
    { const v4u* src = (const v4u*)((const bf16*)(F.ws + WS_WC2_T) + (size_t)kind * 128 * 128);
#pragma unroll
      for (int j = 0; j < 4; ++j) { const int p_ = tid_ + 512 * j; *(LAS v4u*)(L + (p_ >> 4) * 272 + (p_ & 15) * 16) = src[p_]; } }
    __syncthreads();
    const float* cb = (const float*)(F.ws + WS_CBIAS) + kind * 128;
    const int i = 16 * w + idx, ic = (i < NCMP) ? i : 0;
    bf16x8 gf[4];
#pragma unroll
    for (int ks = 0; ks < 4; ++ks) { const int k = 32 * ks + 8 * q;
        const v4u tv = *(const LAS v4u*)(L + CP_TB + ic * CP_TBROW + k * 2), bv = *(const LAS v4u*)(L + CP_TB + (ic + 1) * CP_TBROW + (128 + k) * 2);
        const f32x4 c0 = *(const f32x4*)(cb + k), c1 = *(const f32x4*)(cb + k + 4);
        float h[8];
        h[0] = bf_lo(tv.x) + bf_lo(bv.x) + c0[0]; h[1] = bf_hi(tv.x) + bf_hi(bv.x) + c0[1]; h[2] = bf_lo(tv.y) + bf_lo(bv.y) + c0[2]; h[3] = bf_hi(tv.y) + bf_hi(bv.y) + c0[3];
        h[4] = bf_lo(tv.z) + bf_lo(bv.z) + c1[0]; h[5] = bf_hi(tv.z) + bf_hi(bv.z) + c1[1]; h[6] = bf_lo(tv.w) + bf_lo(bv.w) + c1[2]; h[7] = bf_hi(tv.w) + bf_hi(bv.w) + c1[3];
#pragma unroll
        for (int e = 0; e < 8; ++e) h[e] = (i < NCMP) ? gelu_tanh(h[e]) : 0.f;
        v4u o; o.x = cvtpk(h[0], h[1]); o.y = cvtpk(h[2], h[3]); o.z = cvtpk(h[4], h[5]); o.w = cvtpk(h[6], h[7]);
        gf[ks] = __builtin_bit_cast(bf16x8, o); }
    const LAS unsigned char* W2 = L + idx * 272 + q * 16;
    bf16* outp = (bf16*)(F.ws + WS_CMPP) + ((size_t)bg * 2 + kind) * 16384;
#pragma unroll
    for (int nt = 0; nt < 8; ++nt) {
        f32x4 a2 = {0.f, 0.f, 0.f, 0.f};
        if (kind == 0) {
#pragma unroll
            for (int ks = 0; ks < 4; ++ks) { const bf16x8 wf = *(const LAS bf16x8*)(W2 + nt * (16 * 272) + ks * 64); a2 = mfma16(wf, gf[ks], a2); }
            u32x2v o; o.x = cvtpk(a2[0], a2[1]); o.y = cvtpk(a2[2], a2[3]);
            *(u32x2v*)(outp + (size_t)i * 128 + 16 * nt + 4 * q) = o;
        } else {
#pragma unroll
            for (int ks = 0; ks < 4; ++ks) { const bf16x8 wf = *(const LAS bf16x8*)(W2 + nt * (16 * 272) + ks * 64); a2 = mfma16(gf[ks], wf, a2); }
            u32x2v o; o.x = cvtpk(a2[0], a2[1]); o.y = cvtpk(a2[2], a2[3]);
            *(u32x2v*)(outp + (size_t)(16 * nt + idx) * 128 + 16 * w + 4 * q) = o;
        }
    }
    __syncthreads();
}
#undef CP_LOAD
#undef CP_WRITE
#undef CF_LOAD
#undef CF_WRITE
#undef CF_MMA
#undef CF_LOADB
#undef CF_BAR

constexpr int AT_KROW = 272, AT_VROW = 144;
constexpr int AT_KBUF = 64 * AT_KROW, AT_VBUF = 128 * AT_VROW;
constexpr int AT_K0 = 0, AT_K1 = AT_KBUF, AT_V0 = 2 * AT_KBUF, AT_V1 = AT_V0 + AT_VBUF, AT_SC = AT_V1 + AT_VBUF, AT_ACC = AT_SC + 8192, AT_END = AT_ACC + 8 * 8192;
static_assert(AT_END <= LDSCTL_OFF, "attention LDS");

struct TileRegs { v4u k[2], v[2]; };
__device__ __forceinline__ void tile_load(TileRegs& R, const bf16* ksrc  , const bf16* vsrc  , int vpitch, int tid) {
#pragma unroll
    for (int j = 0; j < 2; ++j) { const int c = tid + 512 * j;
        R.k[j] = *(const v4u*)(ksrc + (size_t)(c >> 4) * 128 + (c & 15) * 8);
        R.v[j] = *(const v4u*)(vsrc + (size_t)(c >> 3) * vpitch + (c & 7) * 8); }
}
__device__ __forceinline__ void tile_store(const TileRegs& R, LAS unsigned char* kb, LAS unsigned char* vb, int tid) {
#pragma unroll
    for (int j = 0; j < 2; ++j) { const int c = tid + 512 * j;
        *(LAS v4u*)(kb + (c >> 4) * AT_KROW + (c & 15) * 16) = R.k[j];
        *(LAS v4u*)(vb + (c >> 3) * AT_VROW + (c & 7) * 16) = R.v[j]; }
}
struct DmaOff { unsigned off[5]; };
__device__ __forceinline__ void dma_setup(DmaOff& D, int w, int lane) {
#pragma unroll
    for (int i = 0; i < 5; ++i) { const int piece = w + 8 * i;
        if (piece < 17) { const int o = 1024 * piece + 16 * lane, row = o / AT_KROW, col = o % AT_KROW; D.off[i] = (col < 256) ? (unsigned)(row * 256 + col) : 0u; }
        else { const int o = 1024 * (piece - 17) + 16 * lane, row = o / AT_VROW, col = o % AT_VROW; D.off[i] = (col < 128 && piece < 35) ? (unsigned)(row * (SEQ * 2) + col) : 0u; } }
}
__device__ __forceinline__ void dma_issue(const DmaOff& D, const bf16* ktile, const bf16* vtile, LAS unsigned char* kb, LAS unsigned char* vb, int w) {
#pragma unroll
    for (int i = 0; i < 5; ++i) { const int piece = w + 8 * i;
        if (piece < 17) __builtin_amdgcn_global_load_lds((const unsigned*)((const char*)ktile + D.off[i]), (LAS unsigned*)(kb + 1024 * piece), 16, 0, 0);
        else if (piece < 35) __builtin_amdgcn_global_load_lds((const unsigned*)((const char*)vtile + D.off[i]), (LAS unsigned*)(vb + 1024 * (piece - 17)), 16, 0, 0); }
}
__device__ __forceinline__ void qk_tile(f32x4 (&s)[4][2], const LAS unsigned char* kb, const bf16x8 (&qf)[2][4], int idx, int q) {
    const LAS unsigned char* kp = kb + idx * AT_KROW + q * 16;
#pragma unroll
    for (int kt = 0; kt < 4; ++kt) { s[kt][0] = (f32x4){0.f, 0.f, 0.f, 0.f}; s[kt][1] = (f32x4){0.f, 0.f, 0.f, 0.f}; }
#pragma unroll
    for (int h = 0; h < 2; ++h) {
        bf16x8 kf[2][4];
#pragma unroll
        for (int k2 = 0; k2 < 2; ++k2)
#pragma unroll
            for (int kt = 0; kt < 4; ++kt) kf[k2][kt] = *(const LAS bf16x8*)(kp + kt * 16 * AT_KROW + (2 * h + k2) * 64);
        __builtin_amdgcn_sched_barrier(0);
#pragma unroll
        for (int k2 = 0; k2 < 2; ++k2)
#pragma unroll
            for (int kt = 0; kt < 4; ++kt) { s[kt][0] = mfma16(kf[k2][kt], qf[0][2 * h + k2], s[kt][0]); s[kt][1] = mfma16(kf[k2][kt], qf[1][2 * h + k2], s[kt][1]); }
        __builtin_amdgcn_sched_barrier(0);
    }
}
struct VHalf { u32x2v v[4][4]; };
__device__ __forceinline__ void v_prefetch(VHalf& V, const LAS unsigned char* vb, int half, int idx, int q) {
    const LAS unsigned char* vp = vb + idx * AT_VROW + q * 8 + half * (64 * AT_VROW);
#pragma unroll
    for (int dt = 0; dt < 4; ++dt)
#pragma unroll
        for (int jj = 0; jj < 2; ++jj) { V.v[dt][2 * jj] = *(const LAS u32x2v*)(vp + dt * 16 * AT_VROW + jj * 64); V.v[dt][2 * jj + 1] = *(const LAS u32x2v*)(vp + dt * 16 * AT_VROW + jj * 64 + 32); }
    __builtin_amdgcn_sched_barrier(0);
}
__device__ __forceinline__ void pv_half(f32x4 (&o)[8][2], int half4, const VHalf& V, const bf16x8 (&pf)[2][2]) {
#pragma unroll
    for (int dt = 0; dt < 4; ++dt)
#pragma unroll
        for (int jj = 0; jj < 2; ++jj) { v4u w; w.x = V.v[dt][2 * jj].x; w.y = V.v[dt][2 * jj].y; w.z = V.v[dt][2 * jj + 1].x; w.w = V.v[dt][2 * jj + 1].y; const bf16x8 vf = __builtin_bit_cast(bf16x8, w);
            o[half4 + dt][0] = mfma16(vf, pf[0][jj], o[half4 + dt][0]); o[half4 + dt][1] = mfma16(vf, pf[1][jj], o[half4 + dt][1]); }
    __builtin_amdgcn_sched_barrier(0);
}
__device__ __forceinline__ void p_pack(bf16x8 (&pf)[2][2], const f32x4 (&p)[4][2]) {
#pragma unroll
    for (int rt = 0; rt < 2; ++rt)
#pragma unroll
        for (int jj = 0; jj < 2; ++jj) { v4u w; w.x = cvtpk(p[2 * jj][rt][0], p[2 * jj][rt][1]); w.y = cvtpk(p[2 * jj][rt][2], p[2 * jj][rt][3]);
            w.z = cvtpk(p[2 * jj + 1][rt][0], p[2 * jj + 1][rt][1]); w.w = cvtpk(p[2 * jj + 1][rt][2], p[2 * jj + 1][rt][3]); pf[rt][jj] = __builtin_bit_cast(bf16x8, w); }
}
__device__ __forceinline__ void pv_tile(f32x4 (&o)[8][2], const LAS unsigned char* vb, const f32x4 (&p)[4][2], int idx, int q) {
    bf16x8 pf[2][2]; p_pack(pf, p);
    { VHalf VA; v_prefetch(VA, vb, 0, idx, q); pv_half(o, 0, VA, pf); }
    { VHalf VB; v_prefetch(VB, vb, 1, idx, q); pv_half(o, 4, VB, pf); }
}
__device__ __forceinline__ void osm_update(f32x4 (&s)[4][2], f32x4 (&o)[8][2], float (&mrow)[2], float (&lrow)[2]) {
    float tmax[2];
#pragma unroll
    for (int rt = 0; rt < 2; ++rt) { float t = s[0][rt][0];
#pragma unroll
        for (int kt = 0; kt < 4; ++kt)
#pragma unroll
            for (int i = 0; i < 4; ++i) t = fmaxf(t, s[kt][rt][i]);
        tmax[rt] = xmax4(t); }
    const bool keep = ((tmax[0] - mrow[0]) * SM_C2 <= 8.f) && ((tmax[1] - mrow[1]) * SM_C2 <= 8.f);
    if (!__all(keep)) {
#pragma unroll
        for (int rt = 0; rt < 2; ++rt) { const float mnew = fmaxf(mrow[rt], tmax[rt]); const float alpha = __builtin_amdgcn_exp2f((mrow[rt] - mnew) * SM_C2); mrow[rt] = mnew; lrow[rt] *= alpha;
#pragma unroll
            for (int dt = 0; dt < 8; ++dt) o[dt][rt] = o[dt][rt] * alpha; }
    }
#pragma unroll
    for (int rt = 0; rt < 2; ++rt) { const float mc = -mrow[rt] * SM_C2; float ps = 0.f;
#pragma unroll
        for (int kt = 0; kt < 4; ++kt)
#pragma unroll
            for (int i = 0; i < 4; ++i) { const float p = __builtin_amdgcn_exp2f(fmaf(s[kt][rt][i], SM_C2, mc)); s[kt][rt][i] = p; ps += p; }
        lrow[rt] += ps; }
}

__device__ __forceinline__ void attn_prompt_unit(Frame& F, int b, int g, int ti) {
    const int tid_ = fresh_tid(F);
    const int tid = tid_, lane = tid & 63, w = F.wave, idx = lane & 15, q = lane >> 4, head = idx & 3;
    LAS unsigned char* L = F.lds + RING_OFF;
    const float NEG = -__builtin_inff();
    const int t0 = ti * 64, bg = b * NG + g;
    const bf16* Qb = (const bf16*)(F.ws + WS_Q);
    const bf16* KSb = (const bf16*)(F.ws + WS_KS) + (size_t)bg * SEQ * 128;   const bf16* VSb = (const bf16*)(F.ws + WS_VST) + (size_t)bg * 128 * SEQ;
    const bf16* KWb = (const bf16*)(F.ws + WS_KW) + (size_t)bg * SEQ * 128;   const bf16* VWb = (const bf16*)(F.ws + WS_VWT) + (size_t)bg * 128 * SEQ;
    const bf16* KCb = (const bf16*)(F.ws + WS_CMPP) + (size_t)(bg * 2 + 0) * 16384; const bf16* VCb = (const bf16*)(F.ws + WS_CMPP) + (size_t)(bg * 2 + 1) * 16384;
    int qpos[2]; bf16x8 qf[2][4];
    const float* const gbase = (const float*)(F.ws + WS_GATES) + (size_t)b * SEQ * 24 + (4 * g + head) * 3;
#pragma unroll
    for (int rt = 0; rt < 2; ++rt) { qpos[rt] = t0 + 8 * w + 4 * rt + (idx >> 2);
        const size_t grow = (size_t)b * SEQ + qpos[rt];
        const bf16* qp = Qb + grow * 1024 + (4 * g + head) * 128 + 8 * q;
#pragma unroll
        for (int ks = 0; ks < 4; ++ks) qf[rt][ks] = *(const bf16x8*)(qp + 32 * ks);
        }
    LAS unsigned char* const accb = L + AT_ACC + w * 8192 + lane * 8;
    unsigned selmask[2];
    {
        TileRegs R;
        tile_load(R, KCb, VCb, 128, tid); tile_store(R, L + AT_K0, L + AT_V0, tid);
        tile_load(R, KCb + 64 * 128, VCb + 64, 128, tid); tile_store(R, L + AT_K1, L + AT_V1, tid);
        __syncthreads();
        f32x4 s0[4][2], s1[4][2];
        qk_tile(s0, L + AT_K0, qf, idx, q); qk_tile(s1, L + AT_K1, qf, idx, q);
        float inv[2];
#pragma unroll
        for (int rt = 0; rt < 2; ++rt) {
            const int nmax = (qpos[rt] - 31) >> 4;
            float tmax = NEG;
#pragma unroll
            for (int kt = 0; kt < 4; ++kt)
#pragma unroll
                for (int i = 0; i < 4; ++i) { const int n0 = 16 * kt + 4 * q + i, n1 = n0 + 64;
                    const float a = (n0 <= nmax) ? s0[kt][rt][i] * SM_C2 : NEG, c = (n1 <= nmax && n1 < NCMP) ? s1[kt][rt][i] * SM_C2 : NEG;
                    s0[kt][rt][i] = a; s1[kt][rt][i] = c; tmax = fmaxf(tmax, fmaxf(a, c)); }
            tmax = xmax4(tmax);
            const float mx = fmaxf(tmax, -1e30f);
            float ps = 0.f;
#pragma unroll
            for (int kt = 0; kt < 4; ++kt)
#pragma unroll
                for (int i = 0; i < 4; ++i) { const float a = __builtin_amdgcn_exp2f(s0[kt][rt][i] - mx), c = __builtin_amdgcn_exp2f(s1[kt][rt][i] - mx); s0[kt][rt][i] = a; s1[kt][rt][i] = c; ps += a + c; }
            ps = xsum4(ps);
            inv[rt] = ps > 0.f ? 1.f / ps : 1.f;
#pragma unroll
            for (int kt = 0; kt < 4; ++kt) { s0[kt][rt] = s0[kt][rt] * inv[rt]; s1[kt][rt] = s1[kt][rt] * inv[rt]; }
        }
        float G8[2][8], L8[2][8];
#pragma unroll
        for (int rt = 0; rt < 2; ++rt)
#pragma unroll
            for (int kt = 0; kt < 4; ++kt) { G8[rt][kt] = (s0[kt][rt][0] + s0[kt][rt][1]) + (s0[kt][rt][2] + s0[kt][rt][3]); L8[rt][kt] = s0[kt][rt][3];
                                             G8[rt][4 + kt] = (s1[kt][rt][0] + s1[kt][rt][1]) + (s1[kt][rt][2] + s1[kt][rt][3]); L8[rt][4 + kt] = s1[kt][rt][3]; }
        {
            f32x4 o[8][2];
#pragma unroll
            for (int dt = 0; dt < 8; ++dt) { o[dt][0] = (f32x4){0.f, 0.f, 0.f, 0.f}; o[dt][1] = (f32x4){0.f, 0.f, 0.f, 0.f}; }
            pv_tile(o, L + AT_V0, s0, idx, q); pv_tile(o, L + AT_V1, s1, idx, q);
#pragma unroll
            for (int dt = 0; dt < 8; ++dt)
#pragma unroll
                for (int rt = 0; rt < 2; ++rt) { const f32x4 v = o[dt][rt] * gbase[(size_t)qpos[rt] * 24]; u32x2v pk; pk.x = cvtpk(v[0], v[1]); pk.y = cvtpk(v[2], v[3]);
                    *(LAS u32x2v*)(accb + (dt * 2 + rt) * 512) = pk; }
        }
        __builtin_amdgcn_sched_barrier(0);
        LAS float* SC = (LAS float*)(L + AT_SC);
#pragma unroll
        for (int rt = 0; rt < 2; ++rt) {
            float T8[8];
#pragma unroll
            for (int k8 = 0; k8 < 8; ++k8) T8[k8] = from_prev_row(L8[rt][k8], q);
            const int jt = ti;
#pragma unroll
            for (int k8 = 0; k8 < 8; ++k8) {
                const float prev = (k8 > 0) ? T8[k8 > 0 ? k8 - 1 : 0] : 0.f;
                float im = G8[rt][k8] + (q == 0 ? prev : T8[k8]);
                im = quad_sum(im);
                const int sb = 4 * k8 + q;
                const bool force = (sb == 0) | (sb == jt) | (sb == jt - 1);
                const float score = force ? 1e4f : ((sb <= jt) ? im : -1.f);
                SC[(w * 8 + 4 * rt + (idx >> 2)) * 32 + sb] = score;
            }
            __builtin_amdgcn_sched_barrier(0);
        }
        LDS_WAIT(); asm volatile("" ::: "memory");
#pragma unroll
        for (int rt = 0; rt < 2; ++rt) {
            const LAS f32x4* sp = (const LAS f32x4*)(SC + (w * 8 + 4 * rt + (idx >> 2)) * 32);
            float sc[32];
#pragma unroll
            for (int k = 0; k < 8; ++k) { const f32x4 v = sp[k]; sc[4 * k] = v[0]; sc[4 * k + 1] = v[1]; sc[4 * k + 2] = v[2]; sc[4 * k + 3] = v[3]; }
            unsigned mk = 0u;
#pragma unroll
            for (int k8 = 0; k8 < 8; ++k8) {
                const float mine = (q == 0) ? sc[4 * k8] : (q == 1) ? sc[4 * k8 + 1] : (q == 2) ? sc[4 * k8 + 2] : sc[4 * k8 + 3];
                const int sb = 4 * k8 + q;
                int rank = 0;
#pragma unroll
                for (int o2 = 0; o2 < 32; ++o2) rank += ((sc[o2] > mine) | ((sc[o2] == mine) & (o2 < sb))) ? 1 : 0;
                mk |= (rank < TOPK) ? (1u << sb) : 0u;
            }
            mk = xor4(mk);
            selmask[rt] = mk;
            __builtin_amdgcn_sched_barrier(0);
        }
        __syncthreads();
    }
#ifndef PROBE_MODE_LO
#define PROBE_MODE_LO 0
#define PROBE_MODE_HI 2
#endif
    DmaOff DO; dma_setup(DO, w, lane);
#pragma unroll 1
    for (int mode = PROBE_MODE_LO; mode < PROBE_MODE_HI; ++mode) {
        const bf16* Kb = mode ? KWb : KSb; const bf16* Vb = mode ? VWb : VSb;
        const int jlo = mode ? ((ti > 8) ? ti - 8 : 0) : 0, jhi = ti;
        f32x4 o[8][2]; float mrow[2] = {-1e30f, -1e30f}, lrow[2] = {0.f, 0.f};
#pragma unroll
        for (int dt = 0; dt < 8; ++dt) { o[dt][0] = (f32x4){0.f, 0.f, 0.f, 0.f}; o[dt][1] = (f32x4){0.f, 0.f, 0.f, 0.f}; }
        dma_issue(DO, Kb + (size_t)jlo * 64 * 128, Vb + jlo * 64, L + AT_K0, L + AT_V0, w);
        asm volatile("s_waitcnt vmcnt(0)" ::: "memory");
        __syncthreads();
#pragma unroll 1
        for (int j = jlo; j <= jhi; ++j) {
            const int par = (j - jlo) & 1;
            LAS unsigned char* kb = L + (par ? AT_K1 : AT_K0); LAS unsigned char* vb = L + (par ? AT_V1 : AT_V0);
            if (j < jhi) dma_issue(DO, Kb + (size_t)(j + 1) * 64 * 128, Vb + (j + 1) * 64, L + (par ? AT_K0 : AT_K1), L + (par ? AT_V0 : AT_V1), w);
            f32x4 s[4][2];
            qk_tile(s, kb, qf, idx, q);
            VHalf VA; v_prefetch(VA, vb, 0, idx, q);
            const int key0 = 64 * j;
            const bool edge = (j == jhi) || (mode && j == ti - 8);
            if (edge) {
#pragma unroll
                for (int rt = 0; rt < 2; ++rt) {
                    const bool rowok = mode ? true : (((selmask[rt] >> j) & 1u) != 0u);
                    const int lo = mode ? qpos[rt] - (WB - 1) : 0;
#pragma unroll
                    for (int kt = 0; kt < 4; ++kt)
#pragma unroll
                        for (int i = 0; i < 4; ++i) { const int key = key0 + 16 * kt + 4 * q + i;
                            const bool ok = rowok && key <= qpos[rt] && key >= lo;
                            s[kt][rt][i] = ok ? s[kt][rt][i] : NEG; }
                }
            } else if (!mode) {
                const bool ok0 = ((selmask[0] >> j) & 1u) != 0u, ok1 = ((selmask[1] >> j) & 1u) != 0u;
                if (!__all(ok0 && ok1)) {
#pragma unroll
                    for (int kt = 0; kt < 4; ++kt)
#pragma unroll
                        for (int i = 0; i < 4; ++i) { s[kt][0][i] = ok0 ? s[kt][0][i] : NEG; s[kt][1][i] = ok1 ? s[kt][1][i] : NEG; }
                }
            }
            osm_update(s, o, mrow, lrow);
            { bf16x8 pf[2][2]; p_pack(pf, s); pv_half(o, 0, VA, pf); v_prefetch(VA, vb, 1, idx, q); pv_half(o, 4, VA, pf); }
            asm volatile("s_waitcnt vmcnt(0)" ::: "memory");
            __syncthreads();
        }
#pragma unroll
        for (int rt = 0; rt < 2; ++rt) { const float l = xsum4(lrow[rt]);
            const float sc = gbase[(size_t)qpos[rt] * 24 + 1 + mode] * (l > 0.f ? 1.f / l : 1.f);
#pragma unroll
            for (int dt = 0; dt < 8; ++dt) { const f32x4 v = o[dt][rt] * sc;
                LAS u32x2v* op = (LAS u32x2v*)(accb + (dt * 2 + rt) * 512);
                u32x2v pk = *op; pk.x = cvtpk(bf_lo(pk.x) + v[0], bf_hi(pk.x) + v[1]); pk.y = cvtpk(bf_lo(pk.y) + v[2], bf_hi(pk.y) + v[3]); *op = pk; } }
    }
    LDS_WAIT(); asm volatile("" ::: "memory");
    { bf16* CC = (bf16*)(F.ws + WS_CONCAT) + ((size_t)b * SEQ + t0 + 8 * w) * DM + 4 * g * 128 + 8 * lane;
      const int hh = lane >> 4, c16 = lane & 15, dts = c16 >> 1, q0 = 2 * (c16 & 1);
#pragma unroll
      for (int T = 0; T < 8; ++T) { const int rt = T >> 2, tl = T & 3;
          const LAS unsigned char* sp = L + AT_ACC + w * 8192 + ((dts * 2 + rt) * 64 + q0 * 16 + tl * 4 + hh) * 8;
          const u32x2v lo = *(const LAS u32x2v*)sp, hi = *(const LAS u32x2v*)(sp + 128);
          v4u o4; o4.x = lo.x; o4.y = lo.y; o4.z = hi.x; o4.w = hi.y;
          *(v4u*)(CC + (size_t)T * DM) = o4; } }
    LDS_WAIT(); asm volatile("" ::: "memory");
}

constexpr int SA_SCC = 0;
constexpr int SA_SSEL = 2048;
constexpr int SA_SWIN = SA_SSEL + 4 * 964 * 4;
constexpr int SA_RED = SA_SWIN + 4 * 512 * 4;
constexpr int SA_MISC = SA_RED + 8 * 4 * 128 * 4;
constexpr int SA_END = SA_MISC + 1024;
static_assert(SA_END <= RING_BYTES, "sample attention LDS");
constexpr int NSELROWS = 15 * 64 + 1;

__device__ __forceinline__ float dot4(const f32x2v (&q2)[4][4], const f32x4 a, const f32x4 b, int c) {
    const f32x2v a01 = {a[0], a[1]}, a23 = {a[2], a[3]}, b01 = {b[0], b[1]}, b23 = {b[2], b[3]};
    float p[4];
#pragma unroll
    for (int h = 0; h < 4; ++h) { f32x2v t = q2[h][0] * a01; t = q2[h][1] * a23 + t; t = q2[h][2] * b01 + t; t = q2[h][3] * b23 + t; p[h] = t.x + t.y; }
    const bool odd = (c & 1) != 0, hi = (c & 2) != 0;
    const float r0 = (odd ? p[1] : p[0]) + dpp_f<0xB1>(odd ? p[0] : p[1]);
    const float r1 = (odd ? p[3] : p[2]) + dpp_f<0xB1>(odd ? p[2] : p[3]);
    float r = (hi ? r1 : r0) + dpp_f<0x4E>(hi ? r0 : r1);
    r += dpp_f<0x128>(r); r += dpp_f<0x124>(r);
    return r * SM_C2;
}
__device__ __forceinline__ void axpy4(float (&acc)[4][8], const float (&p)[4], const f32x4 a, const f32x4 b) {
#pragma unroll
    for (int h = 0; h < 4; ++h) {
#pragma unroll
        for (int e = 0; e < 4; ++e) { acc[h][e] = fmaf(p[h], a[e], acc[h][e]); acc[h][4 + e] = fmaf(p[h], b[e], acc[h][4 + e]); } }
}

__device__ __forceinline__ void attn_sample_unit(Frame& F, const Args& A, int s, int g) {
    const int tid_ = fresh_tid(F);
    const int tid = tid_, lane = tid & 63, w = F.wave, r = lane >> 4, c = lane & 15;
    LAS unsigned char* L = F.lds + RING_OFF;
    LAS float* SCC = (LAS float*)(L + SA_SCC); LAS float* SSEL = (LAS float*)(L + SA_SSEL); LAS float* SWIN = (LAS float*)(L + SA_SWIN);
    LAS float* RED = (LAS float*)(L + SA_RED); LAS int* BLKROW = (LAS int*)(L + SA_MISC); LAS float* COEF = (LAS float*)(L + SA_MISC + 64); LAS float* SCORE = (LAS float*)(L + SA_MISC + 128);
    const int sg = s * 2 + g;
    const float* cache = A.in[2]; const float* swin = A.in[3]; const int* pt = (const int*)A.in[5];
    const bf16* KC = (const bf16*)(F.ws + WS_CMPS) + (size_t)(sg * 2 + 0) * 16384; const bf16* VC = (const bf16*)(F.ws + WS_CMPS) + (size_t)(sg * 2 + 1) * 16384;
    const float* gates = (const float*)(F.ws + WS_GATES) + (size_t)(NPTOK + s) * 24 + 4 * g * 3;
    float* wout = F.out + O_WINS + (size_t)s * WB * 512;
    const float* knew_sel = F.out + O_KVS + (size_t)s * 1024 + 512 + g * 128;
    f32x2v qv[4][4];
    { const bf16* qp = (const bf16*)(F.ws + WS_Q) + (size_t)(NPTOK + s) * 1024 + 4 * g * 128 + 4 * c;
#pragma unroll
      for (int h = 0; h < 4; ++h) { const u32x2v t0 = *(const u32x2v*)(qp + h * 128), t1 = *(const u32x2v*)(qp + h * 128 + 64);
          qv[h][0] = (f32x2v){bf_lo(t0.x), bf_hi(t0.x)}; qv[h][1] = (f32x2v){bf_lo(t0.y), bf_hi(t0.y)}; qv[h][2] = (f32x2v){bf_lo(t1.x), bf_hi(t1.x)}; qv[h][3] = (f32x2v){bf_lo(t1.y), bf_hi(t1.y)}; } }
#define SA_BAR() do { asm volatile("s_waitcnt lgkmcnt(0)" ::: "memory"); __builtin_amdgcn_s_barrier(); asm volatile("" ::: "memory"); } while (0)
    f32x4 ra[8], rb[8];
#define WK_LOAD(grp0_, kind_) do { _Pragma("unroll") for (int u = 0; u < 8; ++u) { const int rho_ = 4 * ((grp0_) + 8 * u) + r; \
        const float* src = (rho_ < 511) ? swin + ((size_t)(s * WB + rho_ + 1) * 2 + (kind_)) * 256 + g * 128 + 4 * c : wout + ((size_t)511 * 2 + (kind_)) * 256 + g * 128 + 4 * c; \
        ra[u] = __builtin_nontemporal_load((const f32x4*)src); rb[u] = __builtin_nontemporal_load((const f32x4*)(src + 64)); } } while (0)
#define WK_COPY(grp0_, kind_) do { _Pragma("unroll") for (int u = 0; u < 8; ++u) { const int rho_ = 4 * ((grp0_) + 8 * u) + r; \
        if (rho_ < 511) { float* dst = wout + ((size_t)rho_ * 2 + (kind_)) * 256 + g * 128 + 4 * c; *(f32x4*)dst = ra[u]; *(f32x4*)(dst + 64) = rb[u]; } } } while (0)
#define SV_LOAD(grp0_) do { _Pragma("unroll") for (int u = 0; u < 8; ++u) { const int rho_ = 4 * ((grp0_) + 8 * u) + r; \
        const float* src = knew_sel + 256 + 4 * c; \
        if (rho_ < 960) src = cache + ((size_t)(BLKROW[rho_ >> 6] + (rho_ & 63))) * 1024 + 768 + g * 128 + 4 * c; \
        ra[u] = __builtin_nontemporal_load((const f32x4*)src); rb[u] = __builtin_nontemporal_load((const f32x4*)(src + 64)); } } while (0)
    WK_LOAD(w, 0);
    for (int grp = w; grp < 32; grp += 8) { const int n = 4 * grp + r;
        const u32x2v t0 = *(const u32x2v*)(KC + (size_t)n * 128 + 4 * c), t1 = *(const u32x2v*)(KC + (size_t)n * 128 + 64 + 4 * c);
        const f32x4 a = {bf_lo(t0.x), bf_hi(t0.x), bf_lo(t0.y), bf_hi(t0.y)}, b = {bf_lo(t1.x), bf_hi(t1.x), bf_lo(t1.y), bf_hi(t1.y)};
        const float sc = dot4(qv, a, b, c);
        if (c < 4) SCC[c * 128 + n] = sc; }
    SA_BAR();
    if (w < 4) { const int h = w;
        const float a = SCC[h * 128 + lane], b = (lane + 64 < NCMP) ? SCC[h * 128 + 64 + lane] : -__builtin_inff();
        const float mx = wave_max(fmaxf(a, b));
        const float ea = __builtin_amdgcn_exp2f(a - mx), eb = __builtin_amdgcn_exp2f(b - mx);
        const float inv = 1.f / wave_sum(ea + eb);
        SCC[h * 128 + lane] = ea * inv; SCC[h * 128 + 64 + lane] = eb * inv; }
    SA_BAR();
    if (w == 0) {
        const int sb = lane;
        float im = 0.f;
        if (sb < NSEL_S) {
#pragma unroll
            for (int k = -1; k < 4; ++k) { const int n = 4 * sb + k; if (n >= 0 && n < NCMP) im += (SCC[n] + SCC[128 + n]) + (SCC[256 + n] + SCC[384 + n]); } }
        const bool force = (sb == 0) || (sb == 32) || (sb == 31);
        const float score = (sb < NSEL_S) ? (force ? 1e4f : im) : -2.f;
        SCORE[lane] = score;
        LDS_WAIT(); asm volatile("" ::: "memory");
        int rank = 0;
        for (int o = 0; o < NSEL_S; ++o) { const float v = SCORE[o]; rank += (v > score || (v == score && o < sb)) ? 1 : 0; }
        const bool sel = (sb < 32) && (rank < TOPK);
        const unsigned long long bm = __ballot(sel);
        const int posn = __popcll(bm & ((1ull << sb) - 1ull));
        if (sel && posn < 15) BLKROW[posn] = pt[s * NPAGES + (sb >> 1)] * PAGE + (sb & 1) * 64;
        if (lane < 12) { const int h = lane / 3, br = lane % 3; if (br == 0) COEF[h] = gates[h * 3]; }
    }
    SA_BAR();
    for (int grp0 = w; grp0 < 128; grp0 += 64) {
        if (grp0 != w) WK_LOAD(grp0, 0);
        WK_COPY(grp0, 0);
#pragma unroll
        for (int u = 0; u < 8; ++u) { const int rho_ = 4 * (grp0 + 8 * u) + r; const float sc = dot4(qv, ra[u], rb[u], c);
            if (c < 4) SWIN[c * 512 + rho_] = sc; }
    }
    for (int grp0 = w; grp0 < 241; grp0 += 64) {
        int rho[8];
#pragma unroll
        for (int u = 0; u < 8; ++u) { const int grp = grp0 + 8 * u; rho[u] = 4 * grp + r;
            const float* src = knew_sel + 4 * c;
            if (rho[u] < 960) src = cache + ((size_t)(BLKROW[rho[u] >> 6] + (rho[u] & 63))) * 1024 + 512 + g * 128 + 4 * c;
            ra[u] = __builtin_nontemporal_load((const f32x4*)src); rb[u] = __builtin_nontemporal_load((const f32x4*)(src + 64)); }
#pragma unroll
        for (int u = 0; u < 8; ++u) { const float sc = dot4(qv, ra[u], rb[u], c);
            if (c < 4 && rho[u] < NSELROWS && grp0 + 8 * u < 241) SSEL[c * 964 + rho[u]] = sc; }
    }
    SV_LOAD(w);
    SA_BAR();
    { const int br = w >> 2, h = w & 3, n = br ? 512 : NSELROWS; LAS float* P = br ? SWIN + h * 512 : SSEL + h * 964;
      float mx = -__builtin_inff();
      for (int i = lane; i < n; i += 64) mx = fmaxf(mx, P[i]);
      mx = wave_max(mx);
      float sum = 0.f;
      for (int i = lane; i < n; i += 64) { const float e = __builtin_amdgcn_exp2f(P[i] - mx); P[i] = e; sum += e; }
      sum = wave_sum(sum);
      if (lane == 0) COEF[(1 + br) * 4 + h] = gates[h * 3 + 1 + br] / sum; }
    SA_BAR();
    float acc[4][8];
#pragma unroll
    for (int h = 0; h < 4; ++h)
#pragma unroll
        for (int e = 0; e < 8; ++e) acc[h][e] = 0.f;
    { float cf[4];
#pragma unroll
      for (int h = 0; h < 4; ++h) cf[h] = COEF[4 + h];
      for (int grp0 = w; grp0 < 241; grp0 += 64) {
          if (grp0 != w) SV_LOAD(grp0);
#pragma unroll
          for (int u = 0; u < 8; ++u) { float p[4]; const int rho_ = 4 * (grp0 + 8 * u) + r; const bool ok = rho_ < NSELROWS && grp0 + 8 * u < 241;
#pragma unroll
              for (int h = 0; h < 4; ++h) p[h] = ok ? SSEL[h * 964 + rho_] * cf[h] : 0.f;
              axpy4(acc, p, ra[u], rb[u]); } } }
    { float cf[4];
#pragma unroll
      for (int h = 0; h < 4; ++h) cf[h] = COEF[h];
      for (int grp = w; grp < 32; grp += 8) { const int n = 4 * grp + r;
          const u32x2v t0 = *(const u32x2v*)(VC + (size_t)n * 128 + 4 * c), t1 = *(const u32x2v*)(VC + (size_t)n * 128 + 64 + 4 * c);
          const f32x4 a = {bf_lo(t0.x), bf_hi(t0.x), bf_lo(t0.y), bf_hi(t0.y)}, b = {bf_lo(t1.x), bf_hi(t1.x), bf_lo(t1.y), bf_hi(t1.y)};
          float p[4];
#pragma unroll
          for (int h = 0; h < 4; ++h) p[h] = SCC[h * 128 + n] * cf[h];
          axpy4(acc, p, a, b); } }
    { float cf[4];
#pragma unroll
      for (int h = 0; h < 4; ++h) cf[h] = COEF[8 + h];
      for (int grp0 = w; grp0 < 128; grp0 += 64) {
          WK_LOAD(grp0, 1);
          WK_COPY(grp0, 1);
#pragma unroll
          for (int u = 0; u < 8; ++u) { float p[4]; const int rho_ = 4 * (grp0 + 8 * u) + r;
#pragma unroll
              for (int h = 0; h < 4; ++h) p[h] = SWIN[h * 512 + rho_] * cf[h];
              axpy4(acc, p, ra[u], rb[u]); } } }
#pragma unroll
    for (int h = 0; h < 4; ++h)
#pragma unroll
        for (int e = 0; e < 8; ++e) acc[h][e] = xsum4(acc[h][e]);
    if (r == 0) {
#pragma unroll
        for (int h = 0; h < 4; ++h) { LAS f32x4* d = (LAS f32x4*)(RED + (w * 4 + h) * 128 + 4 * c);
            d[0] = (f32x4){acc[h][0], acc[h][1], acc[h][2], acc[h][3]}; d[16] = (f32x4){acc[h][4], acc[h][5], acc[h][6], acc[h][7]}; } }
    __syncthreads();
    { float v = 0.f;
#pragma unroll
      for (int ww = 0; ww < 8; ++ww) v += RED[ww * 512 + tid];
      bf16* CC = (bf16*)(F.ws + WS_CONCAT) + (size_t)(NPTOK + s) * DM + 4 * g * 128;
      CC[tid] = (bf16)(cvtpk(v, 0.f) & 0xffffu); }
    __syncthreads();
}
#undef WK_LOAD
#undef WK_COPY
#undef SV_LOAD
#undef SA_BAR

#ifndef P4_ORDER
#define P4_ORDER 2
#endif
#ifndef FUSED_NORM
#define FUSED_NORM 0
#endif
#ifndef MK_N_LAUNCHES
#define MK_N_LAUNCHES 1
#endif
constexpr int N_PHASES = 10;
constexpr int N_LAUNCHES = MK_N_LAUNCHES;

__global__ void __launch_bounds__(NTHREADS, 2) nsa_fwd(Args args) {
    extern __shared__ __attribute__((aligned(16))) unsigned char lds[];
    Frame F;
    F.lds = (LAS unsigned char*)lds;
    F.MISC = (volatile LAS unsigned*)(F.lds + MISC_OFF);
    F.tid = threadIdx.x; F.lane = F.tid & 63; F.wave = __builtin_amdgcn_readfirstlane(F.tid >> 6);
    F.G = gridDim.x; { const int bx = blockIdx.x; F.vcu = (F.G % 8 == 0) ? (bx % 8) * (F.G / 8) + bx / 8 : bx; }
    F.ws = args.ws; F.out = args.out;
    F.ctl = (gu32*)(args.ws + WS_CTL);
    for (int u = F.tid; u < (LDS_BYTES - LDSCTL_OFF) / 4; u += NTHREADS) ((LAS unsigned*)(F.lds + LDSCTL_OFF))[u] = 0u;
    __syncthreads();
    XcdBarrier bar; bar.bar = (unsigned*)(F.ctl + CW_BAR); bar.x = 0; bar.st = nullptr;
    if (N_LAUNCHES == 1) bar = xcd_barrier_post((unsigned*)(F.ctl + CW_BAR), F.MISC + 8);
#define GRID_BAR() do { if (N_LAUNCHES == 1) xcd_barrier(bar); } while (0)
    const int lo = args.ph_lo, hi = args.ph_hi;
#ifndef PH_MASK
#define PH_MASK 0x3ff
#endif
#define IN(k) ((((PH_MASK) >> (k)) & 1) && lo <= (k) && (k) < hi)
#define BOTH(k) (IN(k) && IN((k) + 1))
#ifndef PH_REPEAT
#define PH_REPEAT 0
#endif
#define NREP(k) ((((PH_REPEAT) >> (k)) & 1) ? 2 : 1)

    if (IN(0)) { p0_prologue(F, args); if (BOTH(0)) GRID_BAR(); }

    if (IN(1)) {
        if (F.vcu == 0 && F.tid < 256) { const float* part = (const float*)(F.ws + WS_CBPART) + (size_t)(F.tid >> 7) * 64 * 128 + (F.tid & 127); float s = 0.f;
            for (int p = 0; p < 64; ++p) s += part[p * 128];
            ((float*)(F.ws + WS_CBIAS))[F.tid] = s; }
        if ((blockIdx.x & 1) && args.rep != 1) cmps_fused_phase(F, args, F.vcu, F.G);
        if (args.rep != 2)
        { pg8::Gemm g{(const bf16*)(F.ws + WS_XN), (const bf16*)(F.ws + WS_WIN_T), DM, DM, DM}; pg8::StaticOrder S; S.init(MROWS, NPROJ_PAD, F.G, (int)blockIdx.x);
          EpiProj E{F.ws, F.out, (const float*)(F.ws + WS_ROPE)};
          pg8::gemm_phase<EpiProj, pg8::StaticOrder, true>(F.lds + RING_OFF, g, S, E); }
        if (!(blockIdx.x & 1) && args.rep != 1) cmps_fused_phase(F, args, F.vcu, F.G);
        if (BOTH(1)) GRID_BAR();
    }

    if (IN(2)) {
#ifndef SKIP_A
        if ((args.rep == 0 || args.rep == 1) && (F.vcu & 15) == 0) { const int u16 = F.vcu >> 4; cmpp_fused_unit(F, u16 >> 1, u16 & 1); }
#endif
#ifndef SKIP_B
        if (args.rep == 0 || args.rep == 2) cmp2_phase(F, 0, 512);
#endif
#ifndef SKIP_C
        if (args.rep == 0 || args.rep == 3) pool_phase(F, args, (unsigned*)(F.ctl + CW_QT + 256 * args.pad + 128));
#endif
        p0_transposes_dyn(F, args, TI_SMALL, TI_ALL, (unsigned*)(F.ctl + CW_QT + 256 * args.pad));
        if (BOTH(2)) GRID_BAR();
    }


    if (IN(4)) {
#ifdef PROBE_COPY
        { const bf16* src = (const bf16*)(F.ws + PROBE_COPY_SRC); for (int i = F.vcu * NTHREADS + F.tid; i < PROBE_COPY_N; i += F.G * NTHREADS) F.out[i] = bf2f(src[i]); }
#endif
#ifdef PROBE_COPYF
        { const float* src = (const float*)(F.ws + PROBE_COPYF_SRC); for (int i = F.vcu * NTHREADS + F.tid; i < PROBE_COPYF_N; i += F.G * NTHREADS) F.out[i] = src[i]; }
#endif
        bool first = ((int)blockIdx.x >> 3) < 16 && F.G == 256;
        for (;;) {
            int item;
            if (first) item = ((int)blockIdx.x >> 3) * 8 + ((int)blockIdx.x & 7);
            else {
                if (F.tid == 0) F.MISC[0] = __hip_atomic_fetch_add((unsigned*)(F.ctl + CW_Q3 + 64 * args.pad), 1u, __ATOMIC_RELAXED, __HIP_MEMORY_SCOPE_AGENT);
                __syncthreads();
                item = __builtin_amdgcn_readfirstlane((int)F.MISC[0]) + (F.G == 256 ? 128 : 0);
                __syncthreads();
            }
            first = false;
            if (item >= 512) break;
            int pi = -1, si = -1;
#if P4_ORDER == 1
            if (item < 128) pi = item; else if (item < 448) { const int r = item - 128; if (r % 5 == 4) pi = 128 + r / 5; else si = r - r / 5; } else pi = 192 + (item - 448);
#elif P4_ORDER == 3
            if (item < 64) pi = item; else if (item < 320) si = item - 64; else pi = item - 256;
#elif P4_ORDER == 2
            if (item < 128) pi = item; else if (item < 384) si = item - 128; else pi = item - 256;
#else
            if ((item & 1) == 0) pi = item >> 1; else si = item >> 1;
#endif
#ifndef SKIP_D
            if (pi >= 0 && args.rep != 2) { const int ti = 31 - (pi >> 3), bg = pi & 7; attn_prompt_unit(F, bg >> 1, bg & 1, ti); }
#endif
#ifndef SKIP_E
            if (si >= 0 && args.rep != 1) { attn_sample_unit(F, args, si >> 1, si & 1); }
#endif
        }
        if (BOTH(4)) GRID_BAR();
    }

    if (IN(5)) {
        pg8::Gemm g{(const bf16*)(F.ws + WS_CONCAT), (const bf16*)(F.ws + WS_WO_T), DM, DM, DM}; pg8::StaticOrder S; S.init(NPTOK, DM, F.G, (int)blockIdx.x);
#if FUSED_NORM
        EpiWoFused E{args.in[0], args.in[17], F.out + O_YP, (bf16*)(F.ws + WS_XN),
                     RowExch{(unsigned*)(F.ws + WS_XCH), (unsigned*)(F.ctl + CW_XC), (unsigned*)(F.ctl + CW_TMO)}, RowExch{(unsigned*)(F.ws + WS_XCH + 256 * 1024), (unsigned*)(F.ctl + CW_XC + 4096), (unsigned*)(F.ctl + CW_TMO)}};
        pg8::gemm_phase<EpiWoFused, pg8::StaticOrder, false>(F.lds + RING_OFF, g, S, E);
#else
        EpiBf E{(bf16*)(F.ws + WS_M)};
        pg8::gemm_phase<EpiBf, pg8::StaticOrder, true>(F.lds + RING_OFF, g, S, E);
#endif
        skinny_gemm<1, 8>(F, (const bf16*)(F.ws + WS_CONCAT) + (size_t)NPTOK * DM, (const bf16*)(F.ws + WS_WO_T), DM, DM, SkBf{(bf16*)(F.ws + WS_M) + (size_t)NPTOK * DM, DM});
        if (BOTH(5)) GRID_BAR();
    }

    if (IN(6)) { p5_rows(F, args, FUSED_NORM ? NPTOK : 0); if (BOTH(6)) GRID_BAR();
#ifdef EXTRA_BARS
        for (int xb = 0; xb < EXTRA_BARS; ++xb) GRID_BAR();
#endif
    }

    if (IN(7)) {
        pg8::Gemm g{(const bf16*)(F.ws + WS_XN), (const bf16*)(F.ws + WS_WUP_T), DM, DM, DM}; pg8::StaticOrder S; S.init(NPTOK, DFF, F.G, (int)blockIdx.x);
        EpiUp E{(bf16*)(F.ws + WS_ACT)};
        pg8::gemm_phase<EpiUp, pg8::StaticOrder, true>(F.lds + RING_OFF, g, S, E);
        skinny_gemm<4, 4>(F, (const bf16*)(F.ws + WS_XN) + (size_t)NPTOK * DM, (const bf16*)(F.ws + WS_WUP_T), DM, DFF, SkUp{(bf16*)(F.ws + WS_ACT) + (size_t)NPTOK * DFF});
        if (BOTH(7)) GRID_BAR();
    }

    if (IN(8)) {
        pg8::Gemm g{(const bf16*)(F.ws + WS_ACT), (const bf16*)(F.ws + WS_WDN_T), DFF, DFF, DFF}; pg8::StaticOrder S; S.init(NPTOK, DM, F.G, (int)blockIdx.x);
#if FUSED_NORM
        EpiDownFused E{args.in[21], F.out + O_YP, RowExch{(unsigned*)(F.ws + WS_XCH + 512 * 1024), (unsigned*)(F.ctl + CW_XC + 8192), (unsigned*)(F.ctl + CW_TMO)}};
        pg8::gemm_phase<EpiDownFused, pg8::StaticOrder, false>(F.lds + RING_OFF, g, S, E);
#else
        EpiBf E{(bf16*)(F.ws + WS_M2)};
        pg8::gemm_phase<EpiBf, pg8::StaticOrder, true>(F.lds + RING_OFF, g, S, E);
#endif
        skinny_gemm<1, 8>(F, (const bf16*)(F.ws + WS_ACT) + (size_t)NPTOK * DFF, (const bf16*)(F.ws + WS_WDN_T), DFF, DM, SkBf{(bf16*)(F.ws + WS_M2) + (size_t)NPTOK * DM, DM});
        if (BOTH(8)) GRID_BAR();
    }

    if (IN(9)) { p8_rows(F, args, FUSED_NORM ? NPTOK : 0); }
#undef IN
#undef BOTH
#undef GRID_BAR
}

extern "C" void kernel_launch(void* const* d_in, const int* in_sizes, int n_in, void* d_out, int out_size, void* d_ws, size_t ws_size, hipStream_t stream) {
    static int grid = 0;
    if (grid == 0) {
        if (n_in != 22 || ws_size < WS_END) { fprintf(stderr, "kernel_launch: unexpected shapes (n_in %d, out %d, ws %zu); nothing launched\n", n_in, out_size, ws_size); grid = -1; return; }
        int dev = 0, cus = 0, per_cu = 0;
        if (hipGetDevice(&dev) != hipSuccess || hipDeviceGetAttribute(&cus, hipDeviceAttributeMultiprocessorCount, dev) != hipSuccess) { grid = -1; return; }
        if (hipFuncSetAttribute((const void*)nsa_fwd, hipFuncAttributeMaxDynamicSharedMemorySize, LDS_BYTES) != hipSuccess) { fprintf(stderr, "kernel_launch: hipFuncSetAttribute failed\n"); grid = -1; return; }
        if (hipOccupancyMaxActiveBlocksPerMultiprocessor(&per_cu, (const void*)nsa_fwd, NTHREADS, LDS_BYTES) != hipSuccess || per_cu < 1)
            fprintf(stderr, "kernel_launch: note: occupancy query reports %d workgroups per CU\n", per_cu);
        (void)hipGetLastError();
        grid = cus;
        if (grid != 256) { fprintf(stderr, "kernel_launch: %d CUs; the fused norm epilogues need exactly 256 resident workgroups (one 256x256 unit each); nothing launched\n", grid); grid = -1; return; }
    }
    if (grid < 0) return;
    if (hipMemsetAsync((char*)d_ws + WS_CTL, 0, FUSED_NORM ? CTL_ZERO_BYTES : 64 * 1024, stream) != hipSuccess) { fprintf(stderr, "kernel_launch: memset failed\n"); return; }
    Args a{};
    for (int i = 0; i < 22; ++i) a.in[i] = (const float*)d_in[i];
    a.out = (float*)d_out; a.ws = (unsigned char*)d_ws;
    for (int li = 0; li < N_LAUNCHES; ++li) {
        a.ph_lo = (N_LAUNCHES == 1) ? 0 : li; a.ph_hi = (N_LAUNCHES == 1) ? N_PHASES : li + 1; a.rep = 0; a.pad = 0;
        hipLaunchKernelGGL(nsa_fwd, dim3(grid), dim3(NTHREADS), LDS_BYTES, stream, a);
#ifdef REPEAT_LAUNCH
        if (N_LAUNCHES > 1 && li == REPEAT_LAUNCH) { for (int r = 1; r <= REPEAT_TIMES; ++r) { a.rep = REPEAT_KIND; a.pad = r; hipLaunchKernelGGL(nsa_fwd, dim3(grid), dim3(NTHREADS), LDS_BYTES, stream, a); } }
#endif
#ifdef EMPTY_LAUNCHES
        if (N_LAUNCHES > 1 && li == 5) { Args e = a; e.ph_lo = 10; e.ph_hi = 10; for (int r = 0; r < EMPTY_LAUNCHES; ++r) hipLaunchKernelGGL(nsa_fwd, dim3(grid), dim3(NTHREADS), LDS_BYTES, stream, e); }
#endif
        const hipError_t le = hipPeekAtLastError();
        if (le != hipSuccess) { fprintf(stderr, "kernel_launch: launch %d failed: %s\n", li, hipGetErrorName(le)); break; }
    }
}
```

```cpp
#include <hip/hip_runtime.h>
#include <cstdio>
#include <cstdint>

namespace pg8 {
#define PG8_LAS __attribute__((address_space(3)))
typedef unsigned short bf16_t;
typedef short bf16x8 __attribute__((ext_vector_type(8)));
typedef float f32x4 __attribute__((ext_vector_type(4)));
typedef unsigned u32x4 __attribute__((ext_vector_type(4)));
typedef unsigned u32x2 __attribute__((ext_vector_type(2)));
constexpr int BM = 256, BK = 64, HALF = 128, HTB = HALF * BK * 2  , STAGE_BYTES = 8 * HTB, NXCD = 8, WGM = 8;

__host__ __device__ __forceinline__ int lds_byte(int r, int c) { const int st = (r >> 4) * 2 + (c >> 5), rr = r & 15, cc = c & 31, ob = rr * 64 + cc * 2; return st * 1024 + (ob ^ (((ob >> 9) & 1) << 5)); }
__host__ __device__ __forceinline__ void stage_rc(int b, int& R, int& C) { const int st = b / 1024, sb = b % 1024, swz = sb ^ (((sb >> 9) & 1) << 5); R = (st >> 1) * 16 + swz / 64; C = (st & 1) * 32 + (swz % 64) / 2; }
__host__ __device__ __forceinline__ int perm32(int rho) { const int n = rho >> 4, i = rho & 15; return 8 * (i >> 2) + 4 * n + (i & 3); }

struct Unit { int pm, pn, koff; };
struct Gemm { const bf16_t* A; const bf16_t* Bt; int K, lda, ldb; };

struct StaticOrder {
    int nM, nN, nwg, G, c;
    __host__ __device__ void init(int M, int N, int G_, int c_) { nM = M / BM; nN = N / BM; nwg = nM * nN; G = G_; c = c_; }
    __host__ __device__ bool next(int i, Unit& u) const {
        const long L = (long)i * G + c; if (L >= nwg) return false;
        int wgid = (int)L; { const int q = nwg / NXCD, r = nwg % NXCD, xcd = wgid % NXCD, off = wgid / NXCD; wgid = (xcd < r ? xcd * (q + 1) : r * (q + 1) + (xcd - r) * q) + off; }
        const int nig = WGM * nN, gid = wgid / nig, fm = gid * WGM, gsz = (nM - fm) < WGM ? (nM - fm) : WGM;
        u.pm = fm + ((wgid % nig) % gsz); u.pn = (wgid % nig) / gsz; u.koff = 0; return true;
    }
    __device__ __forceinline__ void a_ready(const Unit&) const {}
    __device__ __forceinline__ void done(const Unit&) const {}
};

__device__ __forceinline__ unsigned cvt_pk_bf16(float lo, float hi) { unsigned r; asm volatile("v_cvt_pk_bf16_f32 %0, %1, %2" : "=v"(r) : "v"(lo), "v"(hi)); return r; }

template <class Epi, class Sched, bool ALIGN_EPI>
__device__ __forceinline__ void gemm_phase(PG8_LAS unsigned char* lds, const Gemm g, const Sched& S, const Epi& E) {
    const int tid = threadIdx.x, wid = __builtin_amdgcn_readfirstlane(tid >> 6), lane = tid & 63, wr = wid >> 2, wc = wid & 3, fr = lane & 15, fq = lane >> 4;
    const int K = g.K, nt = K / BK;
    unsigned voffA[2], voffB[2];
#pragma unroll
    for (int i = 0; i < 2; ++i) { int R, C; stage_rc(tid * 16 + i * 8192, R, C); const int Rb = Epi::PERM ? ((R & ~31) + perm32(R & 31)) : R;
        voffA[i] = (unsigned)(R * g.lda + C) * 2u; voffB[i] = (unsigned)(Rb * g.ldb + C) * 2u; }
    const size_t kstep = (size_t)(BK * 2);
    const size_t hstepA = (size_t)HALF * g.lda * 2, hstepB = (size_t)HALF * g.ldb * 2;
    const size_t tstepA = 2 * hstepA, tstepB = 2 * hstepB;
    const unsigned ldsw = (unsigned)wid * 1024u;
    const int aoff = lds_byte(wr * 64 + fr, fq * 8), boff = lds_byte(wc * 32 + fr, fq * 8);
#define PG8_SA(b, h) (((b) * 2 + (h)) * HTB)
#define PG8_SB(b, h) ((4 + (b) * 2 + (h)) * HTB)
#define PG8_STAGE(bufoff, gbase, voff) do { _Pragma("unroll") for (int _i = 0; _i < 2; ++_i) \
        __builtin_amdgcn_global_load_lds((const unsigned*)((const char*)(gbase) + (voff)[_i]), (PG8_LAS unsigned*)(lds + (bufoff) + ldsw + _i * 8192), 16, 0, 0); } while (0)
#define PG8_LDA(dst, b, h) do { _Pragma("unroll") for (int m = 0; m < 4; ++m) _Pragma("unroll") for (int k = 0; k < 2; ++k) dst[m][k] = *(const PG8_LAS bf16x8*)(lds + PG8_SA(b, h) + aoff + m * 2048 + k * 1024); } while (0)
#define PG8_LDB(dst, b, h) do { _Pragma("unroll") for (int n = 0; n < 2; ++n) _Pragma("unroll") for (int k = 0; k < 2; ++k) dst[n][k] = *(const PG8_LAS bf16x8*)(lds + PG8_SB(b, h) + boff + n * 2048 + k * 1024); } while (0)
#define PG8_MMA(ai, bj, At, Bt) do { __builtin_amdgcn_s_setprio(1); _Pragma("unroll") for (int m = 0; m < 4; ++m) _Pragma("unroll") for (int n = 0; n < 2; ++n) _Pragma("unroll") for (int k = 0; k < 2; ++k) \
        acc[ai][bj][m][n] = __builtin_amdgcn_mfma_f32_16x16x32_bf16(Bt[n][k], At[m][k], acc[ai][bj][m][n], 0, 0, 0); __builtin_amdgcn_s_setprio(0); } while (0)
#define PG8_WAIT_V(n) asm volatile("s_waitcnt vmcnt(" #n ")" ::: "memory")
#define PG8_WAIT_L(n) asm volatile("s_waitcnt lgkmcnt(" #n ")" ::: "memory")
#define PG8_BAR __builtin_amdgcn_s_barrier()
#define PG8_SCHED __builtin_amdgcn_sched_barrier(0)
    Unit cur, nxt; int ui = 0;
    if (!S.next(0, cur)) return;
    f32x4 acc[2][2][4][2];
#pragma unroll
    for (int a = 0; a < 2; ++a)
#pragma unroll
        for (int b = 0; b < 2; ++b)
#pragma unroll
            for (int m = 0; m < 4; ++m)
#pragma unroll
                for (int n = 0; n < 2; ++n) acc[a][b][m][n] = (f32x4){0.f, 0.f, 0.f, 0.f};
    bf16x8 At[4][2], B0[2][2], B1[2][2];
    const char* cA = (const char*)g.A + (size_t)cur.pm * tstepA + (size_t)cur.koff * 2; const char* cB = (const char*)g.Bt + (size_t)cur.pn * tstepB + (size_t)cur.koff * 2;
    S.a_ready(cur);
    PG8_STAGE(PG8_SB(0, 0), cB, voffB); PG8_STAGE(PG8_SB(0, 1), cB + hstepB, voffB); PG8_STAGE(PG8_SA(0, 0), cA, voffA); PG8_STAGE(PG8_SA(0, 1), cA + hstepA, voffA);
    if (wr == 1) PG8_BAR;
    PG8_WAIT_V(2); PG8_BAR;
    PG8_STAGE(PG8_SB(1, 0), cB + kstep, voffB); PG8_STAGE(PG8_SA(1, 0), cA + kstep, voffA); PG8_STAGE(PG8_SB(1, 1), cB + hstepB + kstep, voffB);
    PG8_WAIT_V(6); PG8_BAR;
    for (;;) {
        const bool has_next = S.next(ui + 1, nxt);
        const char* nA = has_next ? (const char*)g.A + (size_t)nxt.pm * tstepA + (size_t)nxt.koff * 2 : cA; const char* nB = has_next ? (const char*)g.Bt + (size_t)nxt.pn * tstepB + (size_t)nxt.koff * 2 : cB;
        for (int t = 0; t < nt; t += 2) {
            const bool last = (t == nt - 2);
            const char* a1 = cA + (size_t)(t + 1) * kstep;
            const char* a2 = last ? nA : cA + (size_t)(t + 2) * kstep; const char* b2 = last ? nB : cB + (size_t)(t + 2) * kstep;
            const char* a3 = a2 + kstep; const char* b3 = b2 + kstep;
            if (last && has_next) S.a_ready(nxt);
            PG8_LDB(B0, 0, 0); PG8_LDB(B1, 0, 1); PG8_SCHED; PG8_LDA(At, 0, 0); PG8_STAGE(PG8_SA(1, 1), a1 + hstepA, voffA);
            PG8_WAIT_V(8); PG8_WAIT_L(0); PG8_BAR; PG8_MMA(0, 0, At, B0); PG8_MMA(0, 1, At, B1); PG8_BAR; PG8_SCHED;
            PG8_LDA(At, 0, 1); PG8_STAGE(PG8_SB(0, 0), b2, voffB); PG8_STAGE(PG8_SB(0, 1), b2 + hstepB, voffB); PG8_STAGE(PG8_SA(0, 0), a2, voffA);
            PG8_WAIT_V(8); PG8_WAIT_L(0); PG8_BAR; PG8_MMA(1, 0, At, B0); PG8_MMA(1, 1, At, B1); PG8_BAR; PG8_SCHED;
            PG8_LDB(B0, 1, 0); PG8_LDB(B1, 1, 1); PG8_SCHED; PG8_LDA(At, 1, 0); PG8_STAGE(PG8_SA(0, 1), a2 + hstepA, voffA);
            PG8_WAIT_V(8); PG8_WAIT_L(0); PG8_BAR; PG8_MMA(0, 0, At, B0); PG8_MMA(0, 1, At, B1); PG8_BAR; PG8_SCHED;
            PG8_LDA(At, 1, 1); PG8_STAGE(PG8_SB(1, 0), b3, voffB); PG8_STAGE(PG8_SB(1, 1), b3 + hstepB, voffB); PG8_STAGE(PG8_SA(1, 0), a3, voffA);
            PG8_WAIT_V(8); PG8_WAIT_L(0); PG8_BAR; PG8_MMA(1, 0, At, B0); PG8_MMA(1, 1, At, B1); PG8_BAR; PG8_SCHED;
        }
        if constexpr (ALIGN_EPI) { if (wr == 0) PG8_BAR; }
        if constexpr (!Epi::AFTER_DRAIN) { E(acc, cur, wr, wc, fr, fq); S.done(cur); }
        if (!has_next) break;
#pragma unroll
        for (int a = 0; a < 2; ++a)
#pragma unroll
            for (int b = 0; b < 2; ++b)
#pragma unroll
                for (int m = 0; m < 4; ++m)
#pragma unroll
                    for (int n = 0; n < 2; ++n) acc[a][b][m][n] = (f32x4){0.f, 0.f, 0.f, 0.f};
        cur = nxt; cA = nA; cB = nB; ++ui;
        if constexpr (ALIGN_EPI) { if (wr == 1) PG8_BAR; }
    }
    PG8_WAIT_V(0);
    if constexpr (!ALIGN_EPI) { if (wr == 0) PG8_BAR; }
    PG8_BAR;
    if constexpr (Epi::AFTER_DRAIN) { E.fused(acc, cur, wr, wc, fr, fq, lds, wid, lane); S.done(cur); }
#undef PG8_SA
#undef PG8_SB
#undef PG8_STAGE
#undef PG8_LDA
#undef PG8_LDB
#undef PG8_MMA
#undef PG8_WAIT_V
#undef PG8_WAIT_L
#undef PG8_BAR
#undef PG8_SCHED
}
}
#define GAS __attribute__((address_space(1)))
#define LAS __attribute__((address_space(3)))
typedef unsigned short bf16;
typedef unsigned v4u __attribute__((ext_vector_type(4)));
typedef float f32x4 __attribute__((ext_vector_type(4)));
typedef short bf16x8 __attribute__((ext_vector_type(8)));
typedef GAS unsigned gu32;
typedef GAS unsigned long long gu64;
#define RLX_AGENT __ATOMIC_RELAXED, __HIP_MEMORY_SCOPE_AGENT
#define LDS_WAIT() asm volatile("s_waitcnt lgkmcnt(0)" ::: "memory")
#define VM_WAIT() asm volatile("s_waitcnt vmcnt(0)" ::: "memory")
__device__ __forceinline__ unsigned long long rt() { return __builtin_amdgcn_s_memrealtime(); }
__device__ __forceinline__ unsigned f2bf(float f) { unsigned u = __builtin_bit_cast(unsigned, f); return (u + 0x7fffu + ((u >> 16) & 1u)) >> 16; }
__device__ __forceinline__ unsigned pk2(float lo, float hi) { return f2bf(lo) | (f2bf(hi) << 16); }

#define XB_TMO      128
#define XB_XCNT(j)  (256  + 64 * (j))
#define XB_XSUB(j)  (1280 + 64 * (j))
#define XB_XGEN(j)  (2304 + 64 * (j))
#define XB_TOP      3328
#define XB_TOPGEN   3392
#define XCD_BAR_WORDS 3456
#define XB_SPIN_CAP (1u << 18)

__device__ __forceinline__ unsigned xb_ld(unsigned* p)              { return __hip_atomic_load(p, __ATOMIC_RELAXED, __HIP_MEMORY_SCOPE_AGENT); }
__device__ __forceinline__ unsigned xb_add(unsigned* p, unsigned v) { return __hip_atomic_fetch_add(p, v, __ATOMIC_RELAXED, __HIP_MEMORY_SCOPE_AGENT); }
__device__ __forceinline__ unsigned xb_xcc_id() { return (unsigned)__builtin_amdgcn_s_getreg((3 << 11) | 20) & 0xFu; }
#define XB_SPIN(cond, bar) do { unsigned _sp = 0; while (cond) { __builtin_amdgcn_s_sleep(1); \
    if ((++_sp & 255u) == 0u) { if (xb_ld(&(bar)[XB_TMO])) break; if (_sp > XB_SPIN_CAP) { atomicAdd(&(bar)[XB_TMO], 1u); break; } } } } while (0)

struct XcdBarrier {
    unsigned* bar; unsigned x;
    volatile LAS unsigned* st;
};

__device__ __forceinline__ XcdBarrier xcd_barrier_post(unsigned* bar, volatile LAS unsigned* st) {
    XcdBarrier b; b.bar = bar; b.x = xb_xcc_id(); b.st = st;
    if (threadIdx.x == 0) (void)xb_add(&bar[XB_XCNT(b.x)], 1u);
    return b;
}
__device__ __forceinline__ void xcd_barrier_complete(unsigned* bar, unsigned x, unsigned& nloc, unsigned& nx) {
    const unsigned G = gridDim.x * gridDim.y * gridDim.z;
    unsigned sum, cnt, mine, sp = 0u;
    for (;;) {
        sum = 0u; cnt = 0u; mine = 0u;
#pragma unroll
        for (unsigned j = 0; j < 16; ++j) { const unsigned c = xb_ld(&bar[XB_XCNT(j)]); sum += c; cnt += (c > 0u) ? 1u : 0u; mine = (j == x) ? c : mine; }
        if (sum == G) break;
        __builtin_amdgcn_s_sleep(1);
        if ((++sp & 255u) == 0u) { if (xb_ld(&bar[XB_TMO])) break; if (sp > XB_SPIN_CAP) { atomicAdd(&bar[XB_TMO], 1u); break; } }
    }
    nloc = mine > 0u ? mine : 1u; nx = cnt > 0u ? cnt : 1u;
}

__device__ __forceinline__ void xcd_barrier(const XcdBarrier& b) {
    asm volatile("s_waitcnt vmcnt(0)" ::: "memory");
    __syncthreads();
    if (threadIdx.x == 0) {
        unsigned* bar = b.bar;
        __builtin_amdgcn_s_waitcnt(0);
        unsigned nloc = b.st[0], nx = b.st[1];
        if (nloc == 0u) { xcd_barrier_complete(bar, b.x, nloc, nx); b.st[0] = nloc; b.st[1] = nx; }
        const unsigned old = xb_add(&bar[XB_XSUB(b.x)], 1u);
        const unsigned gen = old / nloc;
        if (old + 1u == (gen + 1u) * nloc) {
            __builtin_amdgcn_fence(__ATOMIC_RELEASE, "agent");
            asm volatile("s_waitcnt vmcnt(0)" ::: "memory");
            const unsigned og = xb_add(&bar[XB_TOP], 1u);
            const unsigned tg = og / nx;
            if (og + 1u == (tg + 1u) * nx) xb_add(&bar[XB_TOPGEN], 1u);
            else XB_SPIN(xb_ld(&bar[XB_TOPGEN]) == tg, bar);
            __builtin_amdgcn_fence(__ATOMIC_ACQUIRE, "agent");
            xb_add(&bar[XB_XGEN(b.x)], 1u);
            asm volatile("s_waitcnt vmcnt(0)" ::: "memory");
        } else {
            XB_SPIN(xb_ld(&bar[XB_XGEN(b.x)]) == gen, bar);
            __builtin_amdgcn_fence(__ATOMIC_ACQUIRE, "agent");
            asm volatile("s_waitcnt vmcnt(0)" ::: "memory");
        }
    }
    __syncthreads();
}


constexpr int NWAVES = 8, NTHREADS = 512;
constexpr int DM = 2048, NPTOK = 8192, SEQ = 2048, NB = 4, NS = 128, MTOK = NPTOK + NS  , MROWS = 8448  ;
constexpr int NPROJ = 3608, NPROJ_PAD = 3840, DFF = 8192;
constexpr int NHEAD = 8, HD = 128, NG = 2, HPG = 4;
constexpr int NCMP = 127, NSEL_P = 32, NSEL_S = 33, TOPK = 16;
constexpr int NPAGES = 16, PAGE = 128, PAST = 2048, WB = 512;
constexpr float EPS = 1e-6f;
constexpr float SM_SCALE = 0.08838834764831845f;
constexpr float SM_C2 = SM_SCALE * 1.4426950408889634f;

constexpr size_t O_YP = 0, O_YS = O_YP + (size_t)NPTOK * DM, O_KVP = O_YS + (size_t)NS * DM, O_KVS = O_KVP + (size_t)NPTOK * 1024,
                 O_WINP = O_KVS + (size_t)NS * 1024, O_WINS = O_WINP + (size_t)NB * 512 * 512, O_POOLP = O_WINS + (size_t)NS * 512 * 512,
                 O_POOLS = O_POOLP + (size_t)NB * 15 * 1024, O_END = O_POOLS + (size_t)NS * 15 * 1024;

constexpr size_t MiB = 1u << 20;
constexpr size_t WS_CTL = 0, CTL_ZERO_BYTES = 1 * MiB;
constexpr size_t WS_WIN_T = 2 * MiB;
constexpr size_t WS_WO_T = 18 * MiB;
constexpr size_t WS_WUP_T = 26 * MiB;
constexpr size_t WS_WDN_T = 58 * MiB;
constexpr size_t WS_WC1_T = 90 * MiB;
constexpr size_t WS_WC2_T = 92 * MiB;
constexpr size_t WS_POOLW_T = 92 * MiB + 256 * 1024;
constexpr size_t WS_ROPE = 93 * MiB;
constexpr size_t WS_XN = 96 * MiB;
constexpr size_t WS_Q = 130 * MiB;
constexpr size_t WS_KCP = 148 * MiB;
constexpr size_t WS_KS = 156 * MiB;
constexpr size_t WS_VST = 160 * MiB;
constexpr size_t WS_KW = 164 * MiB;
constexpr size_t WS_VWT = 168 * MiB;
constexpr size_t WS_U = 172 * MiB;
constexpr size_t WS_GATES = 190 * MiB;
constexpr size_t WS_TBP = 760 * MiB;
constexpr size_t WS_CMPP = 195 * MiB;
constexpr size_t WS_CMPS = 196 * MiB;
constexpr size_t WS_TBS = 216 * MiB;
constexpr size_t WS_CA = 256 * MiB;
constexpr size_t WS_CONCAT = 520 * MiB;
constexpr size_t WS_M = 556 * MiB;
constexpr size_t WS_M2 = 590 * MiB;
constexpr size_t WS_ACT = 624 * MiB;
constexpr size_t WS_CBPART = 776 * MiB;
constexpr size_t WS_CBIAS = 776 * MiB + 128 * 1024;
constexpr size_t WS_SSP = 777 * MiB;
constexpr size_t WS_WC1F = 782 * MiB;
constexpr size_t WS_XCH = 780 * MiB;
constexpr size_t WS_END = 784 * MiB;
constexpr int CW_TMO = 0, CW_CODE = 1;
constexpr int CW_BAR = 4096;
constexpr int CW_Q3 = 8192;
constexpr int CW_QT = 12288;
constexpr int CW_CBIAS = 8448;
constexpr int CW_SS1 = 16384;
constexpr int CW_SS2 = 32768;
constexpr int CW_XC = 65536;
static_assert((CW_XC + 3 * 4096) * 4 <= (int)CTL_ZERO_BYTES, "CTL");

constexpr int RING_OFF = 0, RING_BYTES = 131072;
constexpr int LDS_BYTES = 147456;
constexpr int LDSCTL_OFF = LDS_BYTES - 1024, MISC_OFF = LDSCTL_OFF + 320;

typedef unsigned u32x2v __attribute__((ext_vector_type(2)));
typedef float f32x2v __attribute__((ext_vector_type(2)));
struct Args { const float* in[22]; float* out; unsigned char* ws; int ph_lo, ph_hi, rep, pad; };
struct Frame {
    LAS unsigned char* lds;
    volatile LAS unsigned* MISC;
    gu32* ctl;
    unsigned char* ws;
    float* out;
    int tid, lane, wave;
    int vcu, G;
};

__device__ __forceinline__ int fresh_tid(const Frame& F) { int l; asm volatile("v_mbcnt_lo_u32_b32 %0, -1, 0\n\tv_mbcnt_hi_u32_b32 %0, -1, %0" : "=v"(l)); return F.wave * 64 + l; }
template <int CTRL> __device__ __forceinline__ float dpp_f(float v) { return __int_as_float(__builtin_amdgcn_update_dpp(0, __float_as_int(v), CTRL, 0xf, 0xf, true)); }
__device__ __forceinline__ float row_sum16(float v) { v += dpp_f<0x128>(v); v += dpp_f<0x124>(v); v += dpp_f<0x122>(v); v += dpp_f<0x121>(v); return v; }
__device__ __forceinline__ float row_max16(float v) { v = fmaxf(v, dpp_f<0x128>(v)); v = fmaxf(v, dpp_f<0x124>(v)); v = fmaxf(v, dpp_f<0x122>(v)); v = fmaxf(v, dpp_f<0x121>(v)); return v; }
__device__ __forceinline__ float quad_sum(float v) { v += dpp_f<0xB1>(v); v += dpp_f<0x4E>(v); return v; }
__device__ __forceinline__ float xmax4(float v) {
    { auto r = __builtin_amdgcn_permlane32_swap(__float_as_uint(v), __float_as_uint(v), false, false); v = fmaxf(__uint_as_float(r[0]), __uint_as_float(r[1])); }
    { auto r = __builtin_amdgcn_permlane16_swap(__float_as_uint(v), __float_as_uint(v), false, false); v = fmaxf(__uint_as_float(r[0]), __uint_as_float(r[1])); }
    return v;
}
__device__ __forceinline__ float xsum4(float v) {
    { auto r = __builtin_amdgcn_permlane32_swap(__float_as_uint(v), __float_as_uint(v), false, false); v = __uint_as_float(r[0]) + __uint_as_float(r[1]); }
    { auto r = __builtin_amdgcn_permlane16_swap(__float_as_uint(v), __float_as_uint(v), false, false); v = __uint_as_float(r[0]) + __uint_as_float(r[1]); }
    return v;
}
__device__ __forceinline__ unsigned xor4(unsigned v) {
    { auto r = __builtin_amdgcn_permlane32_swap(v, v, false, false); v = r[0] | r[1]; }
    { auto r = __builtin_amdgcn_permlane16_swap(v, v, false, false); v = r[0] | r[1]; }
    return v;
}
__device__ __forceinline__ float from_prev_row(float x, int row) {
    const auto s1 = __builtin_amdgcn_permlane16_swap(__float_as_uint(x), __float_as_uint(x), false, false);
    const auto s2 = __builtin_amdgcn_permlane32_swap(s1[1], s1[1], false, false);
    return __uint_as_float((row & 1) ? s1[0] : (row == 0 ? s2[1] : s2[0]));
}
__device__ __forceinline__ float wave_sum(float v) { return xsum4(row_sum16(v)); }
__device__ __forceinline__ float wave_max(float v) { return xmax4(row_max16(v)); }
typedef __bf16 bf16x2_t __attribute__((ext_vector_type(2)));
__device__ __forceinline__ unsigned cvtpk(float lo, float hi) { const f32x2v v = {lo, hi}; const bf16x2_t b = __builtin_convertvector(v, bf16x2_t); return __builtin_bit_cast(unsigned, b); }
__device__ __forceinline__ float bf_lo(unsigned w) { return __uint_as_float(w << 16); }
__device__ __forceinline__ float bf_hi(unsigned w) { return __uint_as_float(w & 0xffff0000u); }
__device__ __forceinline__ float bf2f(bf16 h) { return __uint_as_float(((unsigned)h) << 16); }

struct TDesc { const float* W; bf16* WT; const float* gain; int N, ldw, ldt, row_off, mode, item, nblk; };
__device__ __forceinline__ void p0_t_load(const TDesc& d, float (&v)[32], int lane) {
    const int nblk = d.nblk, kb = d.item / nblk, nb = d.item % nblk, k0 = 64 * kb, n0 = 32 * nb, nn = n0 + (lane & 31);
#pragma unroll
    for (int i = 0; i < 32; ++i) { const int kk = 2 * i + (lane >> 5); v[i] = (nn < d.N) ? __builtin_nontemporal_load(d.W + (size_t)(k0 + kk) * d.ldw + nn) : 0.f; }
}
__device__ __forceinline__ void p0_t_finish(const TDesc& d, const float (&v)[32], LAS float* scr, int lane) {
    const int nblk = d.nblk, kb = d.item / nblk, nb = d.item % nblk, k0 = 64 * kb, n0 = 32 * nb;
#pragma unroll
    for (int i = 0; i < 32; ++i) { const int kk = 2 * i + (lane >> 5); float x = v[i]; if (d.gain) x *= d.gain[k0 + kk]; scr[kk * 33 + (lane & 31)] = x; }
    LDS_WAIT(); asm volatile("" ::: "memory");
    const int c = lane & 7;
#pragma unroll
    for (int j = 0; j < 4; ++j) { const int nl = (lane >> 3) + 8 * j, n = n0 + nl; const LAS float* s = scr + (8 * c) * 33 + nl;
        if (n < d.N) {
            int dest = n;
            if (d.mode == 1) dest = (n < 2560) ? n : ((n < 2584) ? (3584 + (n - 2560)) : (n - 24));
            v4u o; o.x = cvtpk(s[0 * 33], s[1 * 33]); o.y = cvtpk(s[2 * 33], s[3 * 33]); o.z = cvtpk(s[4 * 33], s[5 * 33]); o.w = cvtpk(s[6 * 33], s[7 * 33]);
            *(v4u*)(d.WT + (size_t)(d.row_off + dest) * d.ldt + k0 + 8 * c) = o; } }
    LDS_WAIT(); asm volatile("" ::: "memory");
}
constexpr int TI_IN = 32 * 114  , TI_O = 32 * 64, TI_UP = 32 * 256, TI_DN = 128 * 64, TI_C1 = 32 * 4, TI_C2 = 2 * 4, TI_PW = 4 * 8;
constexpr int TI_SMALL = TI_IN + TI_O + 4 * TI_C1 + 2 * TI_C2 + 4 * TI_PW;
constexpr int TI_ALL = TI_SMALL + TI_DN + TI_UP;
__device__ __forceinline__ TDesc p0_t_decode_(const Args& A, unsigned char* ws, int it);
__device__ __forceinline__ TDesc p0_t_decode(const Args& A, unsigned char* ws, int it) { TDesc d = p0_t_decode_(A, ws, it); if (d.nblk == 0) d.nblk = (d.N + 31) / 32; return d; }
__device__ __forceinline__ TDesc p0_t_decode_(const Args& A, unsigned char* ws, int it) {
    TDesc d; d.gain = nullptr; d.mode = 0; d.row_off = 0; d.nblk = 0;
    int r = it;
    if (r < TI_IN) { d.W = A.in[7]; d.N = NPROJ; d.ldw = NPROJ; d.WT = (bf16*)(ws + WS_WIN_T); d.ldt = DM; d.gain = A.in[6]; d.mode = 1; d.item = r; d.nblk = 114; return d; } r -= TI_IN;
    if (r < TI_O) { d.W = A.in[16]; d.N = DM; d.ldw = DM; d.WT = (bf16*)(ws + WS_WO_T); d.ldt = DM; d.item = r; return d; } r -= TI_O;
    if (r < 4 * TI_C1) { const int kind = r / (2 * TI_C1), half = (r / TI_C1) & 1;
        d.W = A.in[kind ? 12 : 9] + (size_t)half * 2048 * 128; d.N = 128; d.ldw = 128; d.WT = (bf16*)(ws + WS_WC1_T) + (size_t)kind * 256 * 2048; d.ldt = 2048; d.row_off = half * 128; d.item = r % TI_C1; return d; } r -= 4 * TI_C1;
    if (r < 2 * TI_C2) { const int kind = r / TI_C2; d.W = A.in[kind ? 13 : 10]; d.N = 128; d.ldw = 128; d.WT = (bf16*)(ws + WS_WC2_T) + (size_t)kind * 128 * 128; d.ldt = 128; d.item = r % TI_C2; return d; } r -= 2 * TI_C2;
    if (r < 4 * TI_PW) { const int g = r / TI_PW; d.W = A.in[14] + (size_t)g * 256 * 256; d.N = 256; d.ldw = 256; d.WT = (bf16*)(ws + WS_POOLW_T) + (size_t)g * 256 * 256; d.ldt = 256; d.item = r % TI_PW; return d; } r -= 4 * TI_PW;
    if (r < TI_DN) { d.W = A.in[20]; d.N = DM; d.ldw = DM; d.WT = (bf16*)(ws + WS_WDN_T); d.ldt = DFF; d.item = r; return d; } r -= TI_DN;
    { d.W = A.in[19]; d.N = DFF; d.ldw = DFF; d.WT = (bf16*)(ws + WS_WUP_T); d.ldt = DM; d.gain = A.in[18]; d.item = r; return d; }
}
__device__ __forceinline__ void p0_pair_load(const TDesc& d, f32x4 (&v)[16], f32x4 (&g8)[2], int lane) {
    const int nblk = d.nblk, kb = d.item / nblk, nb = d.item % nblk, k0 = 64 * kb, n0 = 32 * nb;
    const float* gp = (d.gain ? d.gain : d.W) + k0 + 8 * (lane & 7);
    g8[0] = *(const f32x4*)gp; g8[1] = *(const f32x4*)(gp + 4);
    const int nq = n0 + 4 * (lane & 15);
    const float* base = d.W + (size_t)(k0 + (lane >> 4)) * d.ldw + (nq < d.N ? nq : 0);
#pragma unroll
    for (int i = 0; i < 16; ++i) v[i] = __builtin_nontemporal_load((const f32x4*)(base + (size_t)(4 * i) * d.ldw));
}
__device__ __forceinline__ void p0_pair_finish(const TDesc& d, const f32x4 (&v)[16], const f32x4 (&g8)[2], LAS float* scr, int lane) {
    const int nblk = d.nblk, kb = d.item / nblk, nb = d.item % nblk, k0 = 64 * kb, n0 = 32 * nb;
#pragma unroll
    for (int i = 0; i < 16; ++i) { const int kk = 4 * i + (lane >> 4); const f32x4 x = v[i];
        LAS float* w = scr + kk * 65 + 4 * (lane & 15); w[0] = x[0]; w[1] = x[1]; w[2] = x[2]; w[3] = x[3]; }
    LDS_WAIT(); asm volatile("" ::: "memory");
    const int c = lane & 7; const bool hg = d.gain != nullptr;
    float gk[8];
#pragma unroll
    for (int e = 0; e < 4; ++e) { gk[e] = hg ? g8[0][e] : 1.f; gk[4 + e] = hg ? g8[1][e] : 1.f; }
#pragma unroll
    for (int j = 0; j < 8; ++j) { const int nl = (lane >> 3) + 8 * j; const LAS float* s = scr + (8 * c) * 65 + nl;
        v4u o; o.x = cvtpk(s[0 * 65] * gk[0], s[1 * 65] * gk[1]); o.y = cvtpk(s[2 * 65] * gk[2], s[3 * 65] * gk[3]); o.z = cvtpk(s[4 * 65] * gk[4], s[5 * 65] * gk[5]); o.w = cvtpk(s[6 * 65] * gk[6], s[7 * 65] * gk[7]);
        const int n = n0 + nl; int dest = n;
        if (d.mode == 1) dest = (n < 2560) ? n : ((n < 2584) ? (3584 + (n - 2560)) : (n - 24));
        if (n < d.N) *(v4u*)(d.WT + (size_t)(d.row_off + dest) * d.ldt + k0 + 8 * c) = o; }
    LDS_WAIT(); asm volatile("" ::: "memory");
}
__device__ __forceinline__ int t_pop(Frame& F, unsigned* qword) {
    if (fresh_tid(F) == 0) F.MISC[1] = __hip_atomic_fetch_add(qword, 1u, __ATOMIC_RELAXED, __HIP_MEMORY_SCOPE_AGENT);
    asm volatile("s_waitcnt lgkmcnt(0)" ::: "memory"); __builtin_amdgcn_s_barrier(); asm volatile("" ::: "memory");
    const int c = __builtin_amdgcn_readfirstlane((int)F.MISC[1]);
    asm volatile("s_waitcnt lgkmcnt(0)" ::: "memory"); __builtin_amdgcn_s_barrier(); asm volatile("" ::: "memory");
    return c;
}
constexpr int T_SCR = 18304;
static_assert(8 * T_SCR <= LDSCTL_OFF, "transposition LDS");
__device__ __forceinline__ void p0_transposes_dyn(Frame& F, const Args& A, int lo, int hi, unsigned* qword) {
    LAS float* scr = (LAS float*)(F.lds + RING_OFF + F.wave * T_SCR);
    const int lane = fresh_tid(F) & 63;
    int c = t_pop(F, qword);
    if (lo + 16 * c >= hi) return;
    TDesc da = p0_t_decode(A, F.ws, lo + 16 * c + 2 * F.wave), db = da;
    f32x4 va[16], vb[16], ga[2], gb[2];
    p0_pair_load(da, va, ga, lane);
    for (;;) {
        c = t_pop(F, qword); const bool vn = lo + 16 * c < hi;
        db = p0_t_decode(A, F.ws, lo + 16 * (vn ? c : 0) + 2 * F.wave); p0_pair_load(db, vb, gb, lane);
        p0_pair_finish(da, va, ga, scr, lane);
        if (!vn) break;
        c = t_pop(F, qword); const bool v2 = lo + 16 * c < hi;
        da = p0_t_decode(A, F.ws, lo + 16 * (v2 ? c : 0) + 2 * F.wave); p0_pair_load(da, va, ga, lane);
        p0_pair_finish(db, vb, gb, scr, lane);
        if (!v2) break;
    }
}
__device__ __forceinline__ void p0_one(Frame& F, const Args& A, int it, int hi, LAS float* scr) {
    const TDesc d0 = p0_t_decode(A, F.ws, it); const bool two = (it + 1) < hi; const TDesc d1 = p0_t_decode(A, F.ws, two ? it + 1 : it);
    if (it + 1 < TI_IN + TI_O) {
        f32x4 v[16], g8[2];
        p0_pair_load(d0, v, g8, F.lane); p0_pair_finish(d0, v, g8, scr, F.lane);
    } else {
        float v0[32], v1[32];
        p0_t_load(d0, v0, F.lane); if (two) p0_t_load(d1, v1, F.lane);
        p0_t_finish(d0, v0, scr, F.lane); if (two) p0_t_finish(d1, v1, scr, F.lane);
    }
}
__device__ __forceinline__ void p0_transposes(Frame& F, const Args& A, int lo, int hi, int vlo) {
    if (F.vcu < vlo) return;
    LAS float* scr = (LAS float*)(F.lds + RING_OFF + F.wave * T_SCR);
    const int gw = (F.vcu - vlo) * NWAVES + F.wave, NGW = (F.G - vlo) * NWAVES;
    for (int it = lo + 2 * gw; it < hi; it += 4 * NGW) {
        const int itb = it + 2 * NGW;
        if (itb + 1 < TI_IN + TI_O) {
            const TDesc da = p0_t_decode(A, F.ws, it), db = p0_t_decode(A, F.ws, itb);
            f32x4 va[16], vb[16], ga[2], gb[2];
            p0_pair_load(da, va, ga, F.lane); p0_pair_load(db, vb, gb, F.lane);
            p0_pair_finish(da, va, ga, scr, F.lane); p0_pair_finish(db, vb, gb, scr, F.lane);
        } else { p0_one(F, A, it, hi, scr); if (itb < hi) p0_one(F, A, itb, hi, scr); }
    }
}
__device__ __forceinline__ void p0_prologue(Frame& F, const Args& A) {
    const int gw = F.vcu * NWAVES + F.wave, NGW = F.G * NWAVES;
    const int gt = F.vcu * NTHREADS + F.tid, NGT = F.G * NTHREADS;
    unsigned char* ws = F.ws;
    p0_transposes(F, A, 0, TI_SMALL, 0);
    { v4u z = {0u, 0u, 0u, 0u};
      v4u* p = (v4u*)(ws + WS_WIN_T + (size_t)NPROJ * DM * 2); const int n1 = (NPROJ_PAD - NPROJ) * DM * 2 / 16;
      for (int i = gt; i < n1; i += NGT) p[i] = z;
      v4u* xz = (v4u*)(ws + WS_XN + (size_t)MTOK * DM * 2); const int n3 = (MROWS - MTOK) * DM * 2 / 16;
      for (int i = gt; i < n3; i += NGT) xz[i] = z; }
    for (int m0 = gw; m0 < MTOK; m0 += 4 * NGW) {
        f32x4 v[4][8]; float s[4] = {0.f, 0.f, 0.f, 0.f};
#pragma unroll
        for (int u = 0; u < 4; ++u) { const int m = m0 + u * NGW;
            if (m < MTOK) { const float* xrow = (m < NPTOK) ? A.in[0] + (size_t)m * DM : A.in[1] + (size_t)(m - NPTOK) * DM; const f32x4* xr = (const f32x4*)xrow + F.lane;
#pragma unroll
                for (int j = 0; j < 8; ++j) v[u][j] = __builtin_nontemporal_load(xr + 64 * j); }
            else {
#pragma unroll
                for (int j = 0; j < 8; ++j) v[u][j] = (f32x4){0.f, 0.f, 0.f, 0.f}; } }
#pragma unroll
        for (int u = 0; u < 4; ++u) {
#pragma unroll
            for (int j = 0; j < 8; ++j) s[u] += (v[u][j].x * v[u][j].x + v[u][j].y * v[u][j].y) + (v[u][j].z * v[u][j].z + v[u][j].w * v[u][j].w); }
#pragma unroll
        for (int u = 0; u < 4; ++u) { const int m = m0 + u * NGW;
            const float rstd = 1.f / sqrtf(wave_sum(s[u]) * (1.f / DM) + EPS);
            if (m < MTOK) { u32x2v* o8 = (u32x2v*)((bf16*)(ws + WS_XN) + (size_t)m * DM) + F.lane;
#pragma unroll
                for (int j = 0; j < 8; ++j) { u32x2v w; w.x = cvtpk(v[u][j].x * rstd, v[u][j].y * rstd); w.y = cvtpk(v[u][j].z * rstd, v[u][j].w * rstd); o8[64 * j] = w; } } }
    }
    { float* rope = (float*)(ws + WS_ROPE);
      for (int i = gt; i < 2049 * 16; i += NGT) { const int pos = i >> 4, k = i & 15;
          const float inv = exp2f(-(float)k * (18.931568569324174f / 16.f));
          const float ang = (float)pos * inv;
          const float kk = rintf(ang * 0.15915494309189535f);
          float r = fmaf(-kk, 6.28125f, ang); r = fmaf(-kk, 1.9353071795864769e-3f, r);
          rope[pos * 32 + k] = __cosf(r); rope[pos * 32 + 16 + k] = __sinf(r); } }
    if (F.vcu < 32) { const int kind = F.vcu >> 4, kc = F.vcu & 15, n = F.tid & 127, kq = F.tid >> 7;
        const float* pe = A.in[kind ? 11 : 8]; const float* w1 = A.in[kind ? 12 : 9];
        float s = 0.f; const int kbeg = kc * 256 + kq * 64;
#pragma unroll 8
        for (int k = kbeg; k < kbeg + 64; ++k) s += pe[k] * w1[(size_t)k * 128 + n];
        ((float*)(ws + WS_CBPART))[(kind * 64 + kc * 4 + kq) * 128 + n] = s; }
    { bf16* WF = (bf16*)(ws + WS_WC1F);
      for (int i = gt; i < 2 * 8 * 16 * 4 * 2 * 64; i += NGT) {
          const int ln = i & 63, nt = (i >> 6) & 1, ks = (i >> 7) & 3, kt = (i >> 9) & 15, w = (i >> 13) & 7, kind = i >> 16;
          const int n = 32 * w + pg8::perm32(16 * nt + (ln & 15)), k = kt * 128 + 32 * ks + 8 * (ln >> 4);
          const float* src = A.in[kind ? 12 : 9] + (size_t)((n >> 7) * 2048 + k) * 128 + (n & 127);
          v4u o; o.x = cvtpk(src[0], src[128]); o.y = cvtpk(src[256], src[384]); o.z = cvtpk(src[512], src[640]); o.w = cvtpk(src[768], src[896]);
          *(v4u*)(WF + (size_t)i * 8) = o; } }
    { const f32x4* sp = (const f32x4*)A.in[4]; f32x4* po = (f32x4*)(F.out + O_POOLS);
      for (int i = gt; i < NS * 14 * 256; i += NGT) { const int s = i / (14 * 256), r = i % (14 * 256); po[s * 15 * 256 + r] = sp[s * 15 * 256 + 256 + r]; } }
}

using pg8::Unit;
using pg8::cvt_pk_bf16;
__device__ __forceinline__ f32x4 swap32(const f32x4 v, bool lower) {
    f32x4 o;
#pragma unroll
    for (int j = 0; j < 4; ++j) { const auto r = __builtin_amdgcn_permlane32_swap(__float_as_uint(v[j]), __float_as_uint(v[j]), false, false); o[j] = __uint_as_float(lower ? r[1] : r[0]); }
    return o;
}
struct EpiProj {
    static constexpr bool PERM = true, AFTER_DRAIN = false;
    unsigned char* ws; float* out; const float* rope;
    __device__ __forceinline__ void operator()(const f32x4 (&acc)[2][2][4][2], const Unit& u, int wr, int wc, int fr, int fq) const {
        const int pn = u.pn;
        const bool roped = ((pn < 4) || pn == 4 || pn == 6 || pn == 8) && wc == 0;
        const int d0 = wc * 32 + 8 * fq;
#pragma unroll
        for (int ai = 0; ai < 2; ++ai)
#pragma unroll
            for (int m = 0; m < 4; ++m) {
                asm volatile("" ::: "memory");
                const int row = u.pm * 256 + ai * 128 + wr * 64 + m * 16 + fr;
                if (row >= MTOK) continue;
                const bool prompt = row < NPTOK;
                const int b = row >> 11, t = row & 2047, s = row - NPTOK, pos = prompt ? t : PAST;
                f32x4 c0 = {1.f, 1.f, 1.f, 1.f}, c1 = c0, s0 = {0.f, 0.f, 0.f, 0.f}, s1 = s0;
                if (roped) { const float* rp = rope + pos * 32 + 8 * (fq & 1); c0 = *(const f32x4*)rp; c1 = *(const f32x4*)(rp + 4); s0 = *(const f32x4*)(rp + 16); s1 = *(const f32x4*)(rp + 20); }
#pragma unroll
                for (int bj = 0; bj < 2; ++bj) {
                    f32x4 v0 = acc[ai][bj][m][0], v1 = acc[ai][bj][m][1];
                    if (roped) { const f32x4 o0 = swap32(v0, fq < 2), o1 = swap32(v1, fq < 2);
                        if (fq < 2) { v0 = v0 * c0 - o0 * s0; v1 = v1 * c1 - o1 * s1; }
                        else        { v0 = o0 * s0 + v0 * c0; v1 = o1 * s1 + v1 * c1; } }
                    v4u pk; pk.x = cvtpk(v0[0], v0[1]); pk.y = cvtpk(v0[2], v0[3]); pk.z = cvtpk(v1[0], v1[1]); pk.w = cvtpk(v1[2], v1[3]);
                    if (pn < 4) {
                        *(v4u*)((bf16*)(ws + WS_Q) + (size_t)row * 1024 + pn * 256 + bj * 128 + d0) = pk;
                    } else if (pn < 8) {
                        float* o = out + (prompt ? O_KVP + (size_t)row * 1024 : O_KVS + (size_t)s * 1024) + (pn - 4) * 256 + bj * 128 + d0;
                        *(f32x4*)o = v0; *(f32x4*)(o + 4) = v1;
                        if (prompt) {
                            if (pn == 4 || pn == 5) *(v4u*)((bf16*)(ws + WS_KCP) + (size_t)(pn - 4) * (NB * NG * SEQ * 128) + ((size_t)(b * NG + bj) * SEQ + t) * 128 + d0) = pk;
                            else if (pn == 6) *(v4u*)((bf16*)(ws + WS_KS) + ((size_t)(b * NG + bj) * SEQ + t) * 128 + d0) = pk;
                            else { bf16* p = (bf16*)(ws + WS_VST) + ((size_t)(b * NG + bj) * 128 + d0) * SEQ + t;
                                p[0] = (bf16)(pk.x & 0xffffu); p[SEQ] = (bf16)(pk.x >> 16); p[2 * SEQ] = (bf16)(pk.y & 0xffffu); p[3 * SEQ] = (bf16)(pk.y >> 16);
                                p[4 * SEQ] = (bf16)(pk.z & 0xffffu); p[5 * SEQ] = (bf16)(pk.z >> 16); p[6 * SEQ] = (bf16)(pk.w & 0xffffu); p[7 * SEQ] = (bf16)(pk.w >> 16); }
                        }
                    } else if (pn < 10) {
                        const int kv = pn - 8;
                        if (prompt) {
                            if (t >= SEQ - WB) { float* o = out + O_WINP + ((size_t)(b * WB + (t - (SEQ - WB))) * 2 + kv) * 256 + bj * 128 + d0; *(f32x4*)o = v0; *(f32x4*)(o + 4) = v1; }
                            if (kv == 0) *(v4u*)((bf16*)(ws + WS_KW) + ((size_t)(b * NG + bj) * SEQ + t) * 128 + d0) = pk;
                            else { bf16* p = (bf16*)(ws + WS_VWT) + ((size_t)(b * NG + bj) * 128 + d0) * SEQ + t;
                                p[0] = (bf16)(pk.x & 0xffffu); p[SEQ] = (bf16)(pk.x >> 16); p[2 * SEQ] = (bf16)(pk.y & 0xffffu); p[3 * SEQ] = (bf16)(pk.y >> 16);
                                p[4 * SEQ] = (bf16)(pk.z & 0xffffu); p[5 * SEQ] = (bf16)(pk.z >> 16); p[6 * SEQ] = (bf16)(pk.w & 0xffffu); p[7 * SEQ] = (bf16)(pk.w >> 16); }
                        } else { float* o = out + O_WINS + ((size_t)(s * WB + (WB - 1)) * 2 + kv) * 256 + bj * 128 + d0; *(f32x4*)o = v0; *(f32x4*)(o + 4) = v1; }
                    } else if (pn < 14) {
                        const int cu = (pn - 10) * 256 + bj * 128 + d0;
                        *(v4u*)((bf16*)(ws + WS_U) + (size_t)row * 1024 + cu) = pk;
                        if (prompt) { if (t >= SEQ - 15) { float* o = out + O_POOLP + (size_t)(b * 15 + (t - (SEQ - 15))) * 1024 + cu; *(f32x4*)o = v0; *(f32x4*)(o + 4) = v1; } }
                        else { float* o = out + O_POOLS + (size_t)(s * 15 + 14) * 1024 + cu; *(f32x4*)o = v0; *(f32x4*)(o + 4) = v1; }
                    } else {
                        if (bj == 0 && wc == 0 && fq < 3) {
                            float* gp = (float*)(ws + WS_GATES) + (size_t)row * 24 + 8 * fq;
                            f32x4 g0, g1;
#pragma unroll
                            for (int j = 0; j < 4; ++j) { g0[j] = 1.f / (1.f + __expf(-v0[j])); g1[j] = 1.f / (1.f + __expf(-v1[j])); }
                            *(f32x4*)gp = g0; *(f32x4*)(gp + 4) = g1; }
                    }
                }
            }
    }
};
struct EpiCmpS {
    static constexpr bool PERM = true, AFTER_DRAIN = false;
    bf16* O;
    __device__ __forceinline__ void operator()(const f32x4 (&acc)[2][2][4][2], const Unit& u, int wr, int wc, int fr, int fq) const {
#pragma unroll
        for (int ai = 0; ai < 2; ++ai)
#pragma unroll
            for (int m = 0; m < 4; ++m) { const int row = u.pm * 256 + ai * 128 + wr * 64 + m * 16 + fr; bf16* rowp = O + (size_t)row * 256 + wc * 32 + 8 * fq;
#pragma unroll
                for (int bj = 0; bj < 2; ++bj) { const f32x4 v0 = acc[ai][bj][m][0], v1 = acc[ai][bj][m][1];
                    v4u w; w.x = cvtpk(v0[0], v0[1]); w.y = cvtpk(v0[2], v0[3]); w.z = cvtpk(v1[0], v1[1]); w.w = cvtpk(v1[2], v1[3]);
                    *(v4u*)(rowp + bj * 128) = w; } }
    }
};
struct CmpSOrder {
    int G, c;
    __device__ bool next(int i, Unit& u) const { const int L = i * G + c; if (L >= 256) return false; u.pm = L; u.pn = L >> 7; u.koff = 0; return true; }
    __device__ __forceinline__ void a_ready(const Unit&) const {}
    __device__ __forceinline__ void done(const Unit&) const {}
};
struct EpiCmpP {
    static constexpr bool PERM = false, AFTER_DRAIN = false;
    float* O;
    __device__ __forceinline__ void operator()(const f32x4 (&acc)[2][2][4][2], const Unit& u, int wr, int wc, int fr, int fq) const {
        float* base = O + (size_t)(u.koff >> 9) * (2048 * 256);
#pragma unroll
        for (int ai = 0; ai < 2; ++ai)
#pragma unroll
            for (int m = 0; m < 4; ++m) { const int row = u.pm * 256 + ai * 128 + wr * 64 + m * 16 + fr; float* rowp = base + (size_t)row * 256 + wc * 32 + 4 * fq;
#pragma unroll
                for (int bj = 0; bj < 2; ++bj)
#pragma unroll
                    for (int n = 0; n < 2; ++n) *(f32x4*)(rowp + bj * 128 + n * 16) = acc[ai][bj][m][n]; }
    }
};
struct CmpPOrder {
    int G, c;
    __device__ bool next(int i, Unit& u) const { const int L = i * G + c; if (c < 0 || L >= 32) return false; u.pm = L >> 2; u.pn = L >> 4; u.koff = (L & 3) * 512; return true; }
    __device__ __forceinline__ void a_ready(const Unit&) const {}
    __device__ __forceinline__ void done(const Unit&) const {}
};
struct EpiBf {
    static constexpr bool PERM = true, AFTER_DRAIN = false;
    bf16* C;
    __device__ __forceinline__ void operator()(const f32x4 (&acc)[2][2][4][2], const Unit& u, int wr, int wc, int fr, int fq) const {
#pragma unroll
        for (int ai = 0; ai < 2; ++ai)
#pragma unroll
            for (int m = 0; m < 4; ++m) { const int row = u.pm * 256 + ai * 128 + wr * 64 + m * 16 + fr; bf16* rowp = C + (size_t)row * DM + u.pn * 256 + wc * 32 + 8 * fq;
#pragma unroll
                for (int bj = 0; bj < 2; ++bj) { const f32x4 v0 = acc[ai][bj][m][0], v1 = acc[ai][bj][m][1];
                    v4u w; w.x = cvtpk(v0[0], v0[1]); w.y = cvtpk(v0[2], v0[3]); w.z = cvtpk(v1[0], v1[1]); w.w = cvtpk(v1[2], v1[3]);
                    *(v4u*)(rowp + bj * 128) = w; } }
    }
};
struct EpiUp {
    static constexpr bool PERM = true, AFTER_DRAIN = false;
    bf16* O;
    __device__ __forceinline__ void operator()(const f32x4 (&acc)[2][2][4][2], const Unit& u, int wr, int wc, int fr, int fq) const {
#pragma unroll
        for (int ai = 0; ai < 2; ++ai)
#pragma unroll
            for (int m = 0; m < 4; ++m) { const int row = u.pm * 256 + ai * 128 + wr * 64 + m * 16 + fr; bf16* rowp = O + (size_t)row * DFF + u.pn * 256 + wc * 32 + 8 * fq;
#pragma unroll
                for (int bj = 0; bj < 2; ++bj) { f32x4 v0 = acc[ai][bj][m][0], v1 = acc[ai][bj][m][1];
#pragma unroll
                    for (int j = 0; j < 4; ++j) { const float a = fmaxf(v0[j], 0.f), c = fmaxf(v1[j], 0.f); v0[j] = a * a; v1[j] = c * c; }
                    v4u w; w.x = cvtpk(v0[0], v0[1]); w.y = cvtpk(v0[2], v0[3]); w.z = cvtpk(v1[0], v1[1]); w.w = cvtpk(v1[2], v1[3]);
                    *(v4u*)(rowp + bj * 128) = w; } }
    }
};

struct RowExch { unsigned* xbuf; unsigned* cnt; unsigned* tmo; };
__device__ __forceinline__ void row_rstd(const RowExch& X, const f32x4 (&v)[2][2][4][2], const Unit& u, int wr, int wc, int fr, int fq, PG8_LAS unsigned char* lds, int wid, int lane) {
    PG8_LAS float* P = (PG8_LAS float*)lds;
    PG8_LAS float* S = (PG8_LAS float*)(lds + 4096);
#pragma unroll
    for (int ai = 0; ai < 2; ++ai)
#pragma unroll
        for (int m = 0; m < 4; ++m) { float q = 0.f;
#pragma unroll
            for (int bj = 0; bj < 2; ++bj)
#pragma unroll
                for (int n = 0; n < 2; ++n) { const f32x4 x = v[ai][bj][m][n]; q += (x[0] * x[0] + x[1] * x[1]) + (x[2] * x[2] + x[3] * x[3]); }
            q = xsum4(q);
            if (fq == 0) P[(ai * 128 + wr * 64 + m * 16 + fr) * 4 + wc] = q; }
    asm volatile("s_waitcnt lgkmcnt(0)" ::: "memory"); __builtin_amdgcn_s_barrier(); asm volatile("" ::: "memory");
    const int row = wid * 32 + (lane & 31);
    if (lane < 32) { const float tot = (P[row * 4 + 0] + P[row * 4 + 1]) + (P[row * 4 + 2] + P[row * 4 + 3]);
        __hip_atomic_store(X.xbuf + ((size_t)(u.pm * 256 + row) * 8 + u.pn), __float_as_uint(tot), __ATOMIC_RELAXED, __HIP_MEMORY_SCOPE_AGENT); }
    asm volatile("s_waitcnt vmcnt(0)" ::: "memory");
    if (lane == 0) __hip_atomic_fetch_add(X.cnt + 64 * u.pm, 1u, __ATOMIC_RELAXED, __HIP_MEMORY_SCOPE_AGENT);
    if (wid == 0) {
        const unsigned long long t0 = __builtin_amdgcn_s_memrealtime();
        for (;;) {
            if ((unsigned)__builtin_amdgcn_readfirstlane(__hip_atomic_load(X.cnt + 64 * u.pm, __ATOMIC_RELAXED, __HIP_MEMORY_SCOPE_AGENT)) >= 64u) break;
            if (__builtin_amdgcn_s_memrealtime() - t0 > 2000000ull) { if (lane == 0) __hip_atomic_store(X.tmo, 1u, __ATOMIC_RELAXED, __HIP_MEMORY_SCOPE_AGENT); break; }
            __builtin_amdgcn_s_sleep(2);
        }
        __builtin_amdgcn_fence(__ATOMIC_ACQUIRE, "agent");
    }
    asm volatile("s_waitcnt vmcnt(0) lgkmcnt(0)" ::: "memory"); __builtin_amdgcn_s_barrier(); asm volatile("" ::: "memory");
    if (lane < 32) { const unsigned* slot = X.xbuf + (size_t)(u.pm * 256 + row) * 8; float t = 0.f;
#pragma unroll
        for (int k = 0; k < 8; ++k) t += __uint_as_float(__hip_atomic_load(slot + k, __ATOMIC_RELAXED, __HIP_MEMORY_SCOPE_AGENT));
        S[row] = 1.f / sqrtf(t * (1.f / DM) + EPS); }
    asm volatile("s_waitcnt lgkmcnt(0)" ::: "memory"); __builtin_amdgcn_s_barrier(); asm volatile("" ::: "memory");
}
struct EpiWoFused {
    static constexpr bool PERM = false, AFTER_DRAIN = true;
    const float* x; const float* gpost; float* out; bf16* xn; RowExch X1, X2;
    __device__ __forceinline__ void operator()(const f32x4 (&)[2][2][4][2], const Unit&, int, int, int, int) const {}
    __device__ __forceinline__ void fused(f32x4 (&acc)[2][2][4][2], const Unit& u, int wr, int wc, int fr, int fq, PG8_LAS unsigned char* lds, int wid, int lane) const {
        const PG8_LAS float* S = (const PG8_LAS float*)(lds + 4096);
        row_rstd(X1, acc, u, wr, wc, fr, fq, lds, wid, lane);
        const int col0 = u.pn * 256 + wc * 32 + 4 * fq;
#pragma unroll
        for (int ai = 0; ai < 2; ++ai)
#pragma unroll
            for (int m = 0; m < 4; ++m) { const int r = ai * 128 + wr * 64 + m * 16 + fr; const float r1 = S[r]; const size_t off = (size_t)(u.pm * 256 + r) * DM + col0;
#pragma unroll
                for (int bj = 0; bj < 2; ++bj)
#pragma unroll
                    for (int n = 0; n < 2; ++n) { const f32x4 xv = *(const f32x4*)(x + off + bj * 128 + n * 16), gv = *(const f32x4*)(gpost + col0 + bj * 128 + n * 16);
                        const f32x4 y = xv + acc[ai][bj][m][n] * gv * r1; acc[ai][bj][m][n] = y; *(f32x4*)(out + off + bj * 128 + n * 16) = y; }
                asm volatile("" : "+v"(acc[ai][0][m][0]), "+v"(acc[ai][0][m][1]), "+v"(acc[ai][1][m][0]), "+v"(acc[ai][1][m][1]));
                asm volatile("" ::: "memory"); }
        row_rstd(X2, acc, u, wr, wc, fr, fq, lds, wid, lane);
#pragma unroll
        for (int ai = 0; ai < 2; ++ai)
#pragma unroll
            for (int m = 0; m < 4; ++m) { const int r = ai * 128 + wr * 64 + m * 16 + fr; const float r2 = S[r]; const size_t off = (size_t)(u.pm * 256 + r) * DM + col0;
#pragma unroll
                for (int bj = 0; bj < 2; ++bj)
#pragma unroll
                    for (int n = 0; n < 2; ++n) { const f32x4 y = acc[ai][bj][m][n] * r2; u32x2v w; w.x = cvtpk(y[0], y[1]); w.y = cvtpk(y[2], y[3]); *(u32x2v*)(xn + off + bj * 128 + n * 16) = w; } }
    }
};
struct EpiDownFused {
    static constexpr bool PERM = false, AFTER_DRAIN = true;
    const float* gpost; float* out; RowExch X;
    __device__ __forceinline__ void operator()(const f32x4 (&)[2][2][4][2], const Unit&, int, int, int, int) const {}
    __device__ __forceinline__ void fused(f32x4 (&acc)[2][2][4][2], const Unit& u, int wr, int wc, int fr, int fq, PG8_LAS unsigned char* lds, int wid, int lane) const {
        const PG8_LAS float* S = (const PG8_LAS float*)(lds + 4096);
        row_rstd(X, acc, u, wr, wc, fr, fq, lds, wid, lane);
        const int col0 = u.pn * 256 + wc * 32 + 4 * fq;
#pragma unroll
        for (int ai = 0; ai < 2; ++ai)
#pragma unroll
            for (int m = 0; m < 4; ++m) { const int r = ai * 128 + wr * 64 + m * 16 + fr; const float rs = S[r]; const size_t off = (size_t)(u.pm * 256 + r) * DM + col0;
#pragma unroll
                for (int bj = 0; bj < 2; ++bj)
#pragma unroll
                    for (int n = 0; n < 2; ++n) { const f32x4 yv = *(const f32x4*)(out + off + bj * 128 + n * 16), gv = *(const f32x4*)(gpost + col0 + bj * 128 + n * 16);
                        *(f32x4*)(out + off + bj * 128 + n * 16) = yv + acc[ai][bj][m][n] * gv * rs; }
                asm volatile("" ::: "memory"); }
    }
};

typedef short s16x4 __attribute__((ext_vector_type(4)));
__device__ __forceinline__ f32x4 mfma16(bf16x8 a, bf16x8 b, f32x4 c) { return __builtin_amdgcn_mfma_f32_16x16x32_bf16(a, b, c, 0, 0, 0); }

constexpr int PL_ROW = 528;
template <int W>
__device__ __forceinline__ void pool_dtile(Frame& F, const Args& A, LAS unsigned char* dl, int tid, int row0, int g) {
    const bf16* U = (const bf16*)(F.ws + WS_U);
    const int c = tid & 255, half = tid >> 8, rfirst = row0 + half * 32;
    const bf16* ucol = U + g * 256 + c;
    if (row0 < NPTOK) {
        const int tfirst = rfirst & 2047;
        float uv[32 + W - 1];
        unsigned short raw[32 + W - 1];
#pragma unroll
        for (int i = 0; i < 32 + W - 1; ++i) { const int t = tfirst - (W - 1) + i; const int tc = t < 0 ? 0 : t; raw[i] = ucol[(size_t)(rfirst - tfirst + tc) * 1024]; }
#pragma unroll
        for (int i = 0; i < 32 + W - 1; ++i) { const int t = tfirst - (W - 1) + i; uv[i] = (t >= 0) ? bf2f(raw[i]) : 0.f; }
        float sum = 0.f;
#pragma unroll
        for (int j = 0; j < W - 1; ++j) sum += uv[j];
#pragma unroll
        for (int i = 0; i < 32; ++i) { const int t = tfirst + i; const float cur = uv[W - 1 + i]; sum += cur;
            const int cnt = (t + 1 < W) ? (t + 1) : W;
            const float d = sum / (float)cnt - cur;
            *(LAS bf16*)(dl + (half * 32 + i) * PL_ROW + c * 2) = (bf16)(cvtpk(d, 0.f) & 0xffffu);
            sum -= uv[i]; }
    } else {
        const float* spool = A.in[4];
#pragma unroll 1
        for (int i0 = 0; i0 < 32; i0 += 4) {
            float v[4][W - 1]; unsigned short cu[4];
#pragma unroll
            for (int u = 0; u < 4; ++u) { const int s = rfirst - NPTOK + i0 + u; cu[u] = ucol[(size_t)(NPTOK + s) * 1024];
#pragma unroll
                for (int j = 0; j < W - 1; ++j) v[u][j] = spool[((size_t)s * 15 + 14 - j) * 1024 + g * 256 + c]; }
#pragma unroll
            for (int u = 0; u < 4; ++u) { const float cur = bf2f(cu[u]); float sum = cur;
#pragma unroll
                for (int j = 0; j < W - 1; ++j) sum += v[u][j];
                const float d = sum / (float)W - cur;
                *(LAS bf16*)(dl + (half * 32 + i0 + u) * PL_ROW + c * 2) = (bf16)(cvtpk(d, 0.f) & 0xffffu); }
        }
    }
}
__device__ __forceinline__ void pool_phase(Frame& F, const Args& A, unsigned* qword) {
    LAS unsigned char* dl = F.lds + RING_OFF;
    const bf16* PW = (const bf16*)(F.ws + WS_POOLW_T); bf16* CC = (bf16*)(F.ws + WS_CONCAT);
    const float* pscale = A.in[15];
    const int tid_ = fresh_tid(F);
    const int lane = tid_ & 63, idx = lane & 15, q = lane >> 4;
    for (;;) {
        if (F.tid == 0) F.MISC[1] = __hip_atomic_fetch_add(qword, 1u, __ATOMIC_RELAXED, __HIP_MEMORY_SCOPE_AGENT);
        __syncthreads();
        const int item = __builtin_amdgcn_readfirstlane((int)F.MISC[1]);
        __syncthreads();
        if (item >= 130 * 4) break;
        const int unit = item < 8 ? 512 + item : item - 8;
        const int tt = unit >> 2, g = unit & 3, w = 2 << g, row0 = tt * 64;
        bf16x8 wf[2][8];
        { const bf16* pwb = PW + ((size_t)g * 256 + 32 * F.wave + idx) * 256 + 8 * q;
#pragma unroll
          for (int nt = 0; nt < 2; ++nt)
#pragma unroll
              for (int ks = 0; ks < 8; ++ks) wf[nt][ks] = *(const bf16x8*)(pwb + (size_t)(16 * nt) * 256 + 32 * ks); }
        if (g == 0) pool_dtile<2>(F, A, dl, tid_, row0, g); else if (g == 1) pool_dtile<4>(F, A, dl, tid_, row0, g); else if (g == 2) pool_dtile<8>(F, A, dl, tid_, row0, g); else pool_dtile<16>(F, A, dl, tid_, row0, g);
        __syncthreads();
        {
            const int w8 = F.wave;
            f32x4 acc[4][2];
#pragma unroll
            for (int mt = 0; mt < 4; ++mt) { acc[mt][0] = (f32x4){0.f, 0.f, 0.f, 0.f}; acc[mt][1] = (f32x4){0.f, 0.f, 0.f, 0.f}; }
#pragma unroll
            for (int ks = 0; ks < 8; ++ks) {
                bf16x8 df[4];
#pragma unroll
                for (int mt = 0; mt < 4; ++mt) df[mt] = *(const LAS bf16x8*)(dl + (16 * mt + idx) * PL_ROW + (32 * ks + 8 * q) * 2);
#pragma unroll
                for (int mt = 0; mt < 4; ++mt) { acc[mt][0] = mfma16(wf[0][ks], df[mt], acc[mt][0]); acc[mt][1] = mfma16(wf[1][ks], df[mt], acc[mt][1]); }
            }
#pragma unroll
            for (int nt = 0; nt < 2; ++nt) { const int e = 32 * w8 + 16 * nt + 4 * q; const f32x4 sc = *(const f32x4*)(pscale + g * 256 + e);
#pragma unroll
                for (int mt = 0; mt < 4; ++mt) { const int row = row0 + 16 * mt + idx;
                    if (row < MTOK) { u32x2v o; o.x = cvtpk(acc[mt][nt][0] * sc[0], acc[mt][nt][1] * sc[1]); o.y = cvtpk(acc[mt][nt][2] * sc[2], acc[mt][nt][3] * sc[3]);
                        *(u32x2v*)(CC + (size_t)row * DM + 1024 + g * 256 + e) = o; } } }
        }
        __syncthreads();
    }
}

__device__ __forceinline__ float gelu_tanh(float x) {
    const float u = 0.7978845608028654f * (x + 0.044715f * x * x * x);
    const float e = __expf(2.f * u);
    const float th = 1.f - 2.f / (e + 1.f);
    return 0.5f * x * (1.f + th);
}
__device__ __forceinline__ void cmp2_phase(Frame& F, int lo, int hi) {
    const int tid_ = fresh_tid(F);
    const int lane = tid_ & 63, idx = lane & 15, q = lane >> 4, w = F.wave;
    const float* cb = (const float*)(F.ws + WS_CBIAS);
    LAS unsigned char* wl = F.lds + RING_OFF;
    { const v4u* src = (const v4u*)(F.ws + WS_WC2_T);
#pragma unroll
      for (int j = 0; j < 8; ++j) { const int cidx = tid_ + 512 * j; *(LAS v4u*)(wl + (cidx >> 4) * 272 + (cidx & 15) * 16) = src[cidx]; } }
    __syncthreads();
    for (int unit = lo + F.vcu; unit < hi; unit += F.G) {
        const bool smp = unit < 512; const int uu = smp ? unit : unit - 512; const int sg = uu >> 1, kind = uu & 1;
        const int i = 16 * w + idx;
        bf16x8 gf[4];
        if (smp) {
            const bf16* TB = (const bf16*)(F.ws + WS_TBS) + ((size_t)kind * 32768 + (size_t)sg * 128) * 256;
#pragma unroll
            for (int ks = 0; ks < 4; ++ks) { const int k = 32 * ks + 8 * q;
                const int ic = (i < NCMP) ? i : 0;
                const v4u tv = *(const v4u*)(TB + (size_t)ic * 256 + k), bv = *(const v4u*)(TB + (size_t)(ic + 1) * 256 + 128 + k);
                const f32x4 c0 = *(const f32x4*)(cb + kind * 128 + k), c1 = *(const f32x4*)(cb + kind * 128 + k + 4);
                float h[8];
                h[0] = bf_lo(tv.x) + bf_lo(bv.x) + c0[0]; h[1] = bf_hi(tv.x) + bf_hi(bv.x) + c0[1]; h[2] = bf_lo(tv.y) + bf_lo(bv.y) + c0[2]; h[3] = bf_hi(tv.y) + bf_hi(bv.y) + c0[3];
                h[4] = bf_lo(tv.z) + bf_lo(bv.z) + c1[0]; h[5] = bf_hi(tv.z) + bf_hi(bv.z) + c1[1]; h[6] = bf_lo(tv.w) + bf_lo(bv.w) + c1[2]; h[7] = bf_hi(tv.w) + bf_hi(bv.w) + c1[3];
#pragma unroll
                for (int e = 0; e < 8; ++e) h[e] = (i < NCMP) ? gelu_tanh(h[e]) : 0.f;
                v4u o; o.x = cvtpk(h[0], h[1]); o.y = cvtpk(h[2], h[3]); o.z = cvtpk(h[4], h[5]); o.w = cvtpk(h[6], h[7]);
                gf[ks] = __builtin_bit_cast(bf16x8, o); }
        } else {
            const float* TB = (const float*)(F.ws + WS_TBP) + ((size_t)kind * 1024 + (size_t)sg * 128) * 256;
#pragma unroll
            for (int ks = 0; ks < 4; ++ks) { const int k = 32 * ks + 8 * q;
                f32x4 t0 = {0.f, 0.f, 0.f, 0.f}, t1 = t0, b0 = t0, b1 = t0;
                {
                    const int ic = (i < NCMP) ? i : 0;
                    f32x4 pv[4][4];
#pragma unroll
                    for (int sl = 0; sl < 4; ++sl) { const float* T8 = TB + (size_t)sl * (2048 * 256);
                        pv[sl][0] = *(const f32x4*)(T8 + (size_t)ic * 256 + k); pv[sl][1] = *(const f32x4*)(T8 + (size_t)ic * 256 + k + 4);
                        pv[sl][2] = *(const f32x4*)(T8 + (size_t)(ic + 1) * 256 + 128 + k); pv[sl][3] = *(const f32x4*)(T8 + (size_t)(ic + 1) * 256 + 128 + k + 4); }
#pragma unroll
                    for (int sl = 0; sl < 4; ++sl) { t0 = t0 + pv[sl][0]; t1 = t1 + pv[sl][1]; b0 = b0 + pv[sl][2]; b1 = b1 + pv[sl][3]; }
                }
                const f32x4 c0 = *(const f32x4*)(cb + kind * 128 + k), c1 = *(const f32x4*)(cb + kind * 128 + k + 4);
                float h[8];
#pragma unroll
                for (int e = 0; e < 4; ++e) { h[e] = t0[e] + b0[e] + c0[e]; h[4 + e] = t1[e] + b1[e] + c1[e]; }
#pragma unroll
                for (int e = 0; e < 8; ++e) h[e] = (i < NCMP) ? gelu_tanh(h[e]) : 0.f;
                v4u o; o.x = cvtpk(h[0], h[1]); o.y = cvtpk(h[2], h[3]); o.z = cvtpk(h[4], h[5]); o.w = cvtpk(h[6], h[7]);
                gf[ks] = __builtin_bit_cast(bf16x8, o); }
        }
        const LAS unsigned char* W2 = wl + kind * (128 * 272) + idx * 272 + q * 16;
        const bool transposed = (!smp) && kind == 1;
        bf16* outp = smp ? (bf16*)(F.ws + WS_CMPS) + ((size_t)sg * 2 + kind) * 16384 : (bf16*)(F.ws + WS_CMPP) + ((size_t)sg * 2 + kind) * 16384;
#pragma unroll
        for (int nt = 0; nt < 8; ++nt) {
            f32x4 acc = {0.f, 0.f, 0.f, 0.f};
            if (!transposed) {
#pragma unroll
                for (int ks = 0; ks < 4; ++ks) { const bf16x8 wf = *(const LAS bf16x8*)(W2 + nt * (16 * 272) + ks * 64); acc = mfma16(wf, gf[ks], acc); }
                u32x2v o; o.x = cvtpk(acc[0], acc[1]); o.y = cvtpk(acc[2], acc[3]);
                *(u32x2v*)(outp + (size_t)i * 128 + 16 * nt + 4 * q) = o;
            } else {
#pragma unroll
                for (int ks = 0; ks < 4; ++ks) { const bf16x8 wf = *(const LAS bf16x8*)(W2 + nt * (16 * 272) + ks * 64); acc = mfma16(gf[ks], wf, acc); }
                u32x2v o; o.x = cvtpk(acc[0], acc[1]); o.y = cvtpk(acc[2], acc[3]);
                *(u32x2v*)(outp + (size_t)(16 * nt + idx) * 128 + 16 * w + 4 * q) = o;
            }
        }
    }
    __syncthreads();
}

template <int NT, int CH, class EpiS>
__device__ __forceinline__ void skinny_gemm(Frame& F, const bf16* A, const bf16* Bt, int K, int N, const EpiS& E) {
    const int tid_ = fresh_tid(F);
    const int lane = tid_ & 63, idx = lane & 15, q = lane >> 4, w = F.wave;
    LAS f32x4* RED = (LAS f32x4*)(F.lds + RING_OFF);
    static_assert(8 * 4 * NT * 64 * 16 <= RING_BYTES, "skinny reduction LDS");
    const int npieces = (N / (16 * NT)) * 2, kw = K / 8, nks = kw / 32;
    for (int piece = F.vcu; piece < npieces; piece += F.G) {
        const int rh = piece & 1, cg = piece >> 1;
        const bf16* ap = A + (size_t)(64 * rh + idx) * K + w * kw + 8 * q;
        const bf16* bp = Bt + (size_t)(16 * NT * cg + idx) * K + w * kw + 8 * q;
        f32x4 acc[NT][4];
#pragma unroll
        for (int nt = 0; nt < NT; ++nt)
#pragma unroll
            for (int mt = 0; mt < 4; ++mt) acc[nt][mt] = (f32x4){0.f, 0.f, 0.f, 0.f};
#pragma unroll 1
        for (int k0 = 0; k0 < nks; k0 += CH) {
            bf16x8 bf[CH][NT], af[CH][4];
#pragma unroll
            for (int j = 0; j < CH; ++j) {
#pragma unroll
                for (int nt = 0; nt < NT; ++nt) bf[j][nt] = *(const bf16x8*)(bp + (size_t)(16 * nt) * K + 32 * (k0 + j));
#pragma unroll
                for (int mt = 0; mt < 4; ++mt) af[j][mt] = *(const bf16x8*)(ap + (size_t)(16 * mt) * K + 32 * (k0 + j)); }
#pragma unroll
            for (int j = 0; j < CH; ++j)
#pragma unroll
                for (int nt = 0; nt < NT; ++nt)
#pragma unroll
                    for (int mt = 0; mt < 4; ++mt) acc[nt][mt] = mfma16(bf[j][nt], af[j][mt], acc[nt][mt]);
        }
#pragma unroll
        for (int nt = 0; nt < NT; ++nt)
#pragma unroll
            for (int mt = 0; mt < 4; ++mt) RED[(w * (4 * NT) + nt * 4 + mt) * 64 + lane] = acc[nt][mt];
        __syncthreads();
        for (int t = w; t < 4 * NT; t += 8) { f32x4 v = RED[t * 64 + lane];
#pragma unroll
            for (int ww = 1; ww < 8; ++ww) v = v + RED[(ww * (4 * NT) + t) * 64 + lane];
            E(64 * rh + 16 * (t & 3) + idx, 16 * (NT * cg + (t >> 2)) + 4 * q, v); }
        __syncthreads();
    }
}
struct SkBf { bf16* C; int ld; __device__ __forceinline__ void operator()(int row, int col, f32x4 v) const { u32x2v o; o.x = cvtpk(v[0], v[1]); o.y = cvtpk(v[2], v[3]); *(u32x2v*)(C + (size_t)row * ld + col) = o; } };
struct SkUp { bf16* O; __device__ __forceinline__ void operator()(int row, int col, f32x4 v) const {
    float a[4];
#pragma unroll
    for (int j = 0; j < 4; ++j) { const float t = fmaxf(v[j], 0.f); a[j] = t * t; }
    u32x2v o; o.x = cvtpk(a[0], a[1]); o.y = cvtpk(a[2], a[3]); *(u32x2v*)(O + (size_t)row * DFF + col) = o; } };

__device__ __forceinline__ void unpack8(float (&f)[8], const v4u t) { f[0] = bf_lo(t.x); f[1] = bf_hi(t.x); f[2] = bf_lo(t.y); f[3] = bf_hi(t.y); f[4] = bf_lo(t.z); f[5] = bf_hi(t.z); f[6] = bf_lo(t.w); f[7] = bf_hi(t.w); }
__device__ __forceinline__ void p5_rows(Frame& F, const Args& A, int mlo) {
    const int lane_ = fresh_tid(F) & 63;
    const int gw = F.vcu * NWAVES + F.wave, NGW = F.G * NWAVES;
    const bf16* Mb = (const bf16*)(F.ws + WS_M); const float* gpost = A.in[17];
    f32x4 GA[4], GB[4];
#pragma unroll
    for (int j = 0; j < 4; ++j) { const int col = 512 * j + 8 * lane_; GA[j] = *(const f32x4*)(gpost + col); GB[j] = *(const f32x4*)(gpost + col + 4); }
    for (int m = mlo + gw; m < MTOK; m += NGW) {
        const float* xrow = (m < NPTOK) ? A.in[0] + (size_t)m * DM : A.in[1] + (size_t)(m - NPTOK) * DM;
        float v[4][8]; f32x4 xa[4], xb[4]; float s1 = 0.f;
#pragma unroll
        for (int j = 0; j < 4; ++j) { const int col = 512 * j + 8 * lane_; unpack8(v[j], __builtin_nontemporal_load((const v4u*)(Mb + (size_t)m * DM + col))); xa[j] = __builtin_nontemporal_load((const f32x4*)(xrow + col)); xb[j] = __builtin_nontemporal_load((const f32x4*)(xrow + col + 4)); }
#pragma unroll
        for (int j = 0; j < 4; ++j)
#pragma unroll
            for (int e = 0; e < 8; ++e) s1 += v[j][e] * v[j][e];
        const float r1 = 1.f / sqrtf(wave_sum(s1) * (1.f / DM) + EPS);
        float s = 0.f;
#pragma unroll
        for (int j = 0; j < 4; ++j) { const int col = 512 * j + 8 * lane_; const f32x4 ga = GA[j], gb = GB[j];
#pragma unroll
            for (int e = 0; e < 4; ++e) { v[j][e] = xa[j][e] + v[j][e] * ga[e] * r1; v[j][4 + e] = xb[j][e] + v[j][4 + e] * gb[e] * r1; }
#pragma unroll
            for (int e = 0; e < 8; ++e) s += v[j][e] * v[j][e]; }
        const float r2 = 1.f / sqrtf(wave_sum(s) * (1.f / DM) + EPS);
#pragma unroll
        for (int j = 0; j < 4; ++j) { const int col = 512 * j + 8 * lane_;
            v4u w; w.x = cvtpk(v[j][0] * r2, v[j][1] * r2); w.y = cvtpk(v[j][2] * r2, v[j][3] * r2); w.z = cvtpk(v[j][4] * r2, v[j][5] * r2); w.w = cvtpk(v[j][6] * r2, v[j][7] * r2);
            *(v4u*)((bf16*)(F.ws + WS_XN) + (size_t)m * DM + col) = w; }
    }
}
__device__ __forceinline__ void p8_rows(Frame& F, const Args& A, int mlo) {
    const int lane_ = fresh_tid(F) & 63;
    const int gw = F.vcu * NWAVES + F.wave, NGW = F.G * NWAVES;
    const bf16* M1 = (const bf16*)(F.ws + WS_M); const bf16* M2 = (const bf16*)(F.ws + WS_M2); const float* g1 = A.in[17]; const float* g2 = A.in[21];
    f32x4 G1a[4], G1b[4], G2a[4], G2b[4];
#pragma unroll
    for (int j = 0; j < 4; ++j) { const int col = 512 * j + 8 * lane_; G1a[j] = *(const f32x4*)(g1 + col); G1b[j] = *(const f32x4*)(g1 + col + 4); G2a[j] = *(const f32x4*)(g2 + col); G2b[j] = *(const f32x4*)(g2 + col + 4); }
    for (int m = mlo + gw; m < MTOK; m += NGW) {
        const float* xrow = (m < NPTOK) ? A.in[0] + (size_t)m * DM : A.in[1] + (size_t)(m - NPTOK) * DM;
        float* orow = F.out + ((m < NPTOK) ? O_YP + (size_t)m * DM : O_YS + (size_t)(m - NPTOK) * DM);
        float v[4][8], u[4][8]; f32x4 xa[4], xb[4]; float s1 = 0.f, s2 = 0.f;
#pragma unroll
        for (int j = 0; j < 4; ++j) { const int col = 512 * j + 8 * lane_; unpack8(v[j], __builtin_nontemporal_load((const v4u*)(M1 + (size_t)m * DM + col))); unpack8(u[j], __builtin_nontemporal_load((const v4u*)(M2 + (size_t)m * DM + col)));
            xa[j] = __builtin_nontemporal_load((const f32x4*)(xrow + col)); xb[j] = __builtin_nontemporal_load((const f32x4*)(xrow + col + 4)); }
#pragma unroll
        for (int j = 0; j < 4; ++j)
#pragma unroll
            for (int e = 0; e < 8; ++e) { s1 += v[j][e] * v[j][e]; s2 += u[j][e] * u[j][e]; }
        const float r1 = 1.f / sqrtf(wave_sum(s1) * (1.f / DM) + EPS);
        const float r2 = 1.f / sqrtf(wave_sum(s2) * (1.f / DM) + EPS);
#pragma unroll
        for (int j = 0; j < 4; ++j) { const int col = 512 * j + 8 * lane_;
            const f32x4 ga = G1a[j], gb = G1b[j], ha = G2a[j], hb = G2b[j];
            f32x4 oa, ob;
#pragma unroll
            for (int e = 0; e < 4; ++e) { const float ya = xa[j][e] + v[j][e] * ga[e] * r1, yb = xb[j][e] + v[j][4 + e] * gb[e] * r1;
                oa[e] = ya + u[j][e] * ha[e] * r2; ob[e] = yb + u[j][4 + e] * hb[e] * r2; }
            *(f32x4*)(orow + col) = oa; *(f32x4*)(orow + col + 4) = ob; }
    }
}

constexpr int CF_ROW = 272, CF_BUF = 128 * CF_ROW;
#define CF_BAR() do { asm volatile("s_waitcnt lgkmcnt(0)" ::: "memory"); __builtin_amdgcn_s_barrier(); asm volatile("" ::: "memory"); } while (0)
#define CF_LOAD(S, kt_) do { _Pragma("unroll") for (int j = 0; j < 8; ++j) S[j] = __builtin_nontemporal_load((const f32x4*)(cbase + (size_t)(PTL[j] + rowc + (unsigned)(kt_) * 4096u))); } while (0)
#define CF_WRITE(S, bufoff) do { _Pragma("unroll") for (int j = 0; j < 8; ++j) { u32x2v o; o.x = cvtpk(S[j].x, S[j].y); o.y = cvtpk(S[j].z, S[j].w); *(LAS u32x2v*)(wr_ + (bufoff) + j * 8 * CF_ROW) = o; } } while (0)
#define CF_LOADB(BX, kt_) do { _Pragma("unroll") for (int ks = 0; ks < 4; ++ks) { BX[0][ks] = *(const bf16x8*)(bp + (size_t)(((kt_) * 4 + ks) * 2 + 0) * 512); BX[1][ks] = *(const bf16x8*)(bp + (size_t)(((kt_) * 4 + ks) * 2 + 1) * 512); } } while (0)
#define CF_MMA(bufoff, BX) do { _Pragma("unroll") for (int ks = 0; ks < 4; ++ks) { _Pragma("unroll") for (int mh = 0; mh < 2; ++mh) { bf16x8 af[4]; \
        _Pragma("unroll") for (int m4 = 0; m4 < 4; ++m4) af[m4] = *(const LAS bf16x8*)(rd_ + (bufoff) + (4 * mh + m4) * 16 * CF_ROW + ks * 64); \
        __builtin_amdgcn_sched_barrier(0); \
        _Pragma("unroll") for (int m4 = 0; m4 < 4; ++m4) { acc[4 * mh + m4][0] = mfma16(BX[0][ks], af[m4], acc[4 * mh + m4][0]); acc[4 * mh + m4][1] = mfma16(BX[1][ks], af[m4], acc[4 * mh + m4][1]); } \
        __builtin_amdgcn_sched_barrier(0); } } } while (0)
__device__ __forceinline__ void cmps_fused_phase(Frame& F, const Args& A, int ufirst, int ustride) {
    const int tid_ = fresh_tid(F);
    const int lane = tid_ & 63, idx = lane & 15, q = lane >> 4, w = F.wave;
    const int lw = tid_ >> 6, lg = (tid_ >> 5) & 1, lcol = tid_ & 31;
    const int* pt = (const int*)A.in[5]; const float* cache = A.in[2];
    LAS unsigned char* L = F.lds + RING_OFF;
    LAS unsigned char* wr_ = L + (lg * 64 + lw) * CF_ROW + lcol * 8;
    const LAS unsigned char* rd_ = L + idx * CF_ROW + q * 16;
    int zero_ = 0; asm volatile("" : "+v"(zero_));
    volatile LAS unsigned* PTL = (volatile LAS unsigned*)(L + 2 * CF_BUF + zero_);
    const unsigned rowc = (unsigned)(16 * lw) * 4096u + lg * 512u + lcol * 16;
    for (int unit = ufirst; unit < 512; unit += ustride) {
        const int kind = unit & 1, ch = (unit >> 1) & 1, s = unit >> 2;
        const char* cbase = (const char*)cache + (size_t)(kind * 256) * 4;
        if (tid_ < 8) PTL[tid_] = (unsigned)pt[s * NPAGES + 8 * ch + tid_] * (PAGE * 4096u);
        __syncthreads();
        const bf16* bp = (const bf16*)(F.ws + WS_WC1F) + (size_t)(kind * 8 + w) * (16 * 4 * 2 * 512) + lane * 8;
        f32x4 acc[8][2];
#pragma unroll
        for (int mt = 0; mt < 8; ++mt) { acc[mt][0] = (f32x4){0.f, 0.f, 0.f, 0.f}; acc[mt][1] = (f32x4){0.f, 0.f, 0.f, 0.f}; }
        f32x4 s0[8], s1[8]; bf16x8 b0[2][4], b1[2][4];
        CF_LOADB(b0, 0); CF_LOAD(s0, 0); CF_LOAD(s1, 1);
        CF_WRITE(s0, 0);
        CF_BAR();
#pragma unroll 1
        for (int kt = 0; kt < 14; kt += 2) {
            CF_LOADB(b1, kt + 1); CF_LOAD(s0, kt + 2);
            CF_MMA(0, b0);
            CF_WRITE(s1, CF_BUF);
            CF_BAR();
            CF_LOADB(b0, kt + 2); CF_LOAD(s1, kt + 3);
            CF_MMA(CF_BUF, b1);
            CF_WRITE(s0, 0);
            CF_BAR();
        }
        CF_LOADB(b1, 15);
        CF_MMA(0, b0);
        CF_WRITE(s1, CF_BUF);
        CF_BAR();
        CF_MMA(CF_BUF, b1);
        CF_BAR();
        bf16* op = (bf16*)(F.ws + WS_TBS) + ((size_t)kind * 32768 + (size_t)(s * 2) * 128 + 64 * ch + idx) * 256 + 32 * w + 8 * q;
#pragma unroll
        for (int mt = 0; mt < 8; ++mt) {
            v4u o; o.x = cvtpk(acc[mt][0][0], acc[mt][0][1]); o.y = cvtpk(acc[mt][0][2], acc[mt][0][3]); o.z = cvtpk(acc[mt][1][0], acc[mt][1][1]); o.w = cvtpk(acc[mt][1][2], acc[mt][1][3]);
            *(v4u*)(op + (size_t)((mt >> 2) * 128 + 16 * (mt & 3)) * 256) = o; }
    }
}

constexpr int CP_TB = 2 * CF_BUF + 64, CP_TBROW = 528;
#define CP_LOAD(S, kt_) do { _Pragma("unroll") for (int j = 0; j < 4; ++j) { const int p_ = tid_ + 512 * j; S[j] = *(const v4u*)(Ak + ((size_t)(16 * (p_ >> 4) + (kt_))) * 128 + (p_ & 15) * 8); } } while (0)
#define CP_WRITE(S, bufoff) do { _Pragma("unroll") for (int j = 0; j < 4; ++j) { const int p_ = tid_ + 512 * j; *(LAS v4u*)(L + (bufoff) + (p_ >> 4) * CF_ROW + (p_ & 15) * 16) = S[j]; } } while (0)
__device__ __forceinline__ void cmpp_fused_unit(Frame& F, int bg, int kind) {
    const int tid_ = fresh_tid(F);
    const int lane = tid_ & 63, idx = lane & 15, q = lane >> 4, w = F.wave;
    LAS unsigned char* L = F.lds + RING_OFF;
    const LAS unsigned char* rd_ = L + idx * CF_ROW + q * 16;
    const bf16* Ak = (const bf16*)(F.ws + WS_KCP) + (size_t)kind * (NB * NG * SEQ * 128) + (size_t)bg * SEQ * 128;
    const bf16* bp = (const bf16*)(F.ws + WS_WC1F) + (size_t)(kind * 8 + w) * (16 * 4 * 2 * 512) + lane * 8;
    f32x4 acc[8][2];
#pragma unroll
    for (int mt = 0; mt < 8; ++mt) { acc[mt][0] = (f32x4){0.f, 0.f, 0.f, 0.f}; acc[mt][1] = (f32x4){0.f, 0.f, 0.f, 0.f}; }
    v4u s0[4], s1[4]; bf16x8 b0[2][4], b1[2][4];
    CF_LOADB(b0, 0); CP_LOAD(s0, 0); CP_LOAD(s1, 1);
    CP_WRITE(s0, 0);
    CF_BAR();
#pragma unroll 1
    for (int kt = 0; kt < 14; kt += 2) {
        CF_LOADB(b1, kt + 1); CP_LOAD(s0, kt + 2);
        CF_MMA(0, b0);
        CP_WRITE(s1, CF_BUF);
        CF_BAR();
        CF_LOADB(b0, kt + 2); CP_LOAD(s1, kt + 3);
        CF_MMA(CF_BUF, b1);
        CP_WRITE(s0, 0);
        CF_BAR();
    }
    CF_LOADB(b1, 15);
    CF_MMA(0, b0);
    CP_WRITE(s1, CF_BUF);
    CF_BAR();
    CF_MMA(CF_BUF, b1);
    CF_BAR();
#pragma unroll
    for (int mt = 0; mt < 8; ++mt) { v4u o; o.x = cvtpk(acc[mt][0][0], acc[mt][0][1]); o.y = cvtpk(acc[mt][0][2], acc[mt][0][3]); o.z = cvtpk(acc[mt][1][0], acc[mt][1][1]); o.w = cvtpk(acc[mt][1][2], acc[mt][1][3]);
        *(LAS v4u*)(L + CP_TB + (16 * mt + idx) * CP_TBROW + (32 * w + 8 * q) * 2) = o; }
    { const v4u* src = (const v4u*)((const bf16*)(F.ws + WS_WC2_T) + (size_t)kind * 128 * 128);
#pragma unroll
      for (int j = 0; j < 4; ++j) { const int p_ = tid_ + 512 * j; *(LAS v4u*)(L + (p_ >> 4) * 272 + (p_ & 15) * 16) = src[p_]; } }
    __syncthreads();
    const float* cb = (const float*)(F.ws + WS_CBIAS) + kind * 128;
    const int i = 16 * w + idx, ic = (i < NCMP) ? i : 0;
    bf16x8 gf[4];
#pragma unroll
    for (int ks = 0; ks < 4; ++ks) { const int k = 32 * ks + 8 * q;
        const v4u tv = *(const LAS v4u*)(L + CP_TB + ic * CP_TBROW + k * 2), bv = *(const LAS v4u*)(L + CP_TB + (ic + 1) * CP_TBROW + (128 + k) * 2);
        const f32x4 c0 = *(const f32x4*)(cb + k), c1 = *(const f32x4*)(cb + k + 4);
        float h[8];
        h[0] = bf_lo(tv.x) + bf_lo(bv.x) + c0[0]; h[1] = bf_hi(tv.x) + bf_hi(bv.x) + c0[1]; h[2] = bf_lo(tv.y) + bf_lo(bv.y) + c0[2]; h[3] = bf_hi(tv.y) + bf_hi(bv.y) + c0[3];
        h[4] = bf_lo(tv.z) + bf_lo(bv.z) + c1[0]; h[5] = bf_hi(tv.z) + bf_hi(bv.z) + c1[1]; h[6] = bf_lo(tv.w) + bf_lo(bv.w) + c1[2]; h[7] = bf_hi(tv.w) + bf_hi(bv.w) + c1[3];
#pragma unroll
        for (int e = 0; e < 8; ++e) h[e] = (i < NCMP) ? gelu_tanh(h[e]) : 0.f;
        v4u o; o.x = cvtpk(h[0], h[1]); o.y = cvtpk(h[2], h[3]); o.z = cvtpk(h[4], h[5]); o.w = cvtpk(h[6], h[7]);
        gf[ks] = __builtin_bit_cast(bf16x8, o); }
    const LAS unsigned char* W2 = L + idx * 272 + q * 16;
    bf16* outp = (bf16*)(F.ws + WS_CMPP) + ((size_t)bg * 2 + kind) * 16384;
#pragma unroll
    for (int nt = 0; nt < 8; ++nt) {
        f32x4 a2 = {0.f, 0.f, 0.f, 0.f};
        if (kind == 0) {
#pragma unroll
            for (int ks = 0; ks < 4; ++ks) { const bf16x8 wf = *(const LAS bf16x8*)(W2 + nt * (16 * 272) + ks * 64); a2 = mfma16(wf, gf[ks], a2); }
            u32x2v o; o.x = cvtpk(a2[0], a2[1]); o.y = cvtpk(a2[2], a2[3]);
            *(u32x2v*)(outp + (size_t)i * 128 + 16 * nt + 4 * q) = o;
        } else {
#pragma unroll
            for (int ks = 0; ks < 4; ++ks) { const bf16x8 wf = *(const LAS bf16x8*)(W2 + nt * (16 * 272) + ks * 64); a2 = mfma16(gf[ks], wf, a2); }
            u32x2v o; o.x = cvtpk(a2[0], a2[1]); o.y = cvtpk(a2[2], a2[3]);
            *(u32x2v*)(outp + (size_t)(16 * nt + idx) * 128 + 16 * w + 4 * q) = o;
        }
    }
    __syncthreads();
}
#undef CP_LOAD
#undef CP_WRITE
#undef CF_LOAD
#undef CF_WRITE
#undef CF_MMA
#undef CF_LOADB
#undef CF_BAR

constexpr int AT_KROW = 272, AT_VROW = 144;
constexpr int AT_KBUF = 64 * AT_KROW, AT_VBUF = 128 * AT_VROW;
constexpr int AT_K0 = 0, AT_K1 = AT_KBUF, AT_V0 = 2 * AT_KBUF, AT_V1 = AT_V0 + AT_VBUF, AT_SC = AT_V1 + AT_VBUF, AT_ACC = AT_SC + 8192, AT_END = AT_ACC + 8 * 8192;
static_assert(AT_END <= LDSCTL_OFF, "attention LDS");

struct TileRegs { v4u k[2], v[2]; };
__device__ __forceinline__ void tile_load(TileRegs& R, const bf16* ksrc  , const bf16* vsrc  , int vpitch, int tid) {
#pragma unroll
    for (int j = 0; j < 2; ++j) { const int c = tid + 512 * j;
        R.k[j] = *(const v4u*)(ksrc + (size_t)(c >> 4) * 128 + (c & 15) * 8);
        R.v[j] = *(const v4u*)(vsrc + (size_t)(c >> 3) * vpitch + (c & 7) * 8); }
}
__device__ __forceinline__ void tile_store(const TileRegs& R, LAS unsigned char* kb, LAS unsigned char* vb, int tid) {
#pragma unroll
    for (int j = 0; j < 2; ++j) { const int c = tid + 512 * j;
        *(LAS v4u*)(kb + (c >> 4) * AT_KROW + (c & 15) * 16) = R.k[j];
        *(LAS v4u*)(vb + (c >> 3) * AT_VROW + (c & 7) * 16) = R.v[j]; }
}
struct DmaOff { unsigned off[5]; };
__device__ __forceinline__ void dma_setup(DmaOff& D, int w, int lane) {
#pragma unroll
    for (int i = 0; i < 5; ++i) { const int piece = w + 8 * i;
        if (piece < 17) { const int o = 1024 * piece + 16 * lane, row = o / AT_KROW, col = o % AT_KROW; D.off[i] = (col < 256) ? (unsigned)(row * 256 + col) : 0u; }
        else { const int o = 1024 * (piece - 17) + 16 * lane, row = o / AT_VROW, col = o % AT_VROW; D.off[i] = (col < 128 && piece < 35) ? (unsigned)(row * (SEQ * 2) + col) : 0u; } }
}
__device__ __forceinline__ void dma_issue(const DmaOff& D, const bf16* ktile, const bf16* vtile, LAS unsigned char* kb, LAS unsigned char* vb, int w) {
#pragma unroll
    for (int i = 0; i < 5; ++i) { const int piece = w + 8 * i;
        if (piece < 17) __builtin_amdgcn_global_load_lds((const unsigned*)((const char*)ktile + D.off[i]), (LAS unsigned*)(kb + 1024 * piece), 16, 0, 0);
        else if (piece < 35) __builtin_amdgcn_global_load_lds((const unsigned*)((const char*)vtile + D.off[i]), (LAS unsigned*)(vb + 1024 * (piece - 17)), 16, 0, 0); }
}
__device__ __forceinline__ void qk_tile(f32x4 (&s)[4][2], const LAS unsigned char* kb, const bf16x8 (&qf)[2][4], int idx, int q) {
    const LAS unsigned char* kp = kb + idx * AT_KROW + q * 16;
#pragma unroll
    for (int kt = 0; kt < 4; ++kt) { s[kt][0] = (f32x4){0.f, 0.f, 0.f, 0.f}; s[kt][1] = (f32x4){0.f, 0.f, 0.f, 0.f}; }
#pragma unroll
    for (int h = 0; h < 2; ++h) {
        bf16x8 kf[2][4];
#pragma unroll
        for (int k2 = 0; k2 < 2; ++k2)
#pragma unroll
            for (int kt = 0; kt < 4; ++kt) kf[k2][kt] = *(const LAS bf16x8*)(kp + kt * 16 * AT_KROW + (2 * h + k2) * 64);
        __builtin_amdgcn_sched_barrier(0);
        __builtin_amdgcn_s_setprio(1);
#pragma unroll
        for (int k2 = 0; k2 < 2; ++k2)
#pragma unroll
            for (int kt = 0; kt < 4; ++kt) { s[kt][0] = mfma16(kf[k2][kt], qf[0][2 * h + k2], s[kt][0]); s[kt][1] = mfma16(kf[k2][kt], qf[1][2 * h + k2], s[kt][1]); }
        __builtin_amdgcn_s_setprio(0);
        __builtin_amdgcn_sched_barrier(0);
    }
}
struct VHalf { u32x2v v[4][4]; };
__device__ __forceinline__ void v_prefetch(VHalf& V, const LAS unsigned char* vb, int half, int idx, int q) {
    const LAS unsigned char* vp = vb + idx * AT_VROW + q * 8 + half * (64 * AT_VROW);
#pragma unroll
    for (int dt = 0; dt < 4; ++dt)
#pragma unroll
        for (int jj = 0; jj < 2; ++jj) { V.v[dt][2 * jj] = *(const LAS u32x2v*)(vp + dt * 16 * AT_VROW + jj * 64); V.v[dt][2 * jj + 1] = *(const LAS u32x2v*)(vp + dt * 16 * AT_VROW + jj * 64 + 32); }
    __builtin_amdgcn_sched_barrier(0);
}
__device__ __forceinline__ void pv_half(f32x4 (&o)[8][2], int half4, const VHalf& V, const bf16x8 (&pf)[2][2]) {
    __builtin_amdgcn_s_setprio(1);
#pragma unroll
    for (int dt = 0; dt < 4; ++dt)
#pragma unroll
        for (int jj = 0; jj < 2; ++jj) { v4u w; w.x = V.v[dt][2 * jj].x; w.y = V.v[dt][2 * jj].y; w.z = V.v[dt][2 * jj + 1].x; w.w = V.v[dt][2 * jj + 1].y; const bf16x8 vf = __builtin_bit_cast(bf16x8, w);
            o[half4 + dt][0] = mfma16(vf, pf[0][jj], o[half4 + dt][0]); o[half4 + dt][1] = mfma16(vf, pf[1][jj], o[half4 + dt][1]); }
    __builtin_amdgcn_s_setprio(0);
    __builtin_amdgcn_sched_barrier(0);
}
__device__ __forceinline__ void p_pack(bf16x8 (&pf)[2][2], const f32x4 (&p)[4][2]) {
#pragma unroll
    for (int rt = 0; rt < 2; ++rt)
#pragma unroll
        for (int jj = 0; jj < 2; ++jj) { v4u w; w.x = cvtpk(p[2 * jj][rt][0], p[2 * jj][rt][1]); w.y = cvtpk(p[2 * jj][rt][2], p[2 * jj][rt][3]);
            w.z = cvtpk(p[2 * jj + 1][rt][0], p[2 * jj + 1][rt][1]); w.w = cvtpk(p[2 * jj + 1][rt][2], p[2 * jj + 1][rt][3]); pf[rt][jj] = __builtin_bit_cast(bf16x8, w); }
}
__device__ __forceinline__ void pv_tile(f32x4 (&o)[8][2], const LAS unsigned char* vb, const f32x4 (&p)[4][2], int idx, int q) {
    bf16x8 pf[2][2]; p_pack(pf, p);
    { VHalf VA; v_prefetch(VA, vb, 0, idx, q); pv_half(o, 0, VA, pf); }
    { VHalf VB; v_prefetch(VB, vb, 1, idx, q); pv_half(o, 4, VB, pf); }
}
__device__ __forceinline__ void osm_update(f32x4 (&s)[4][2], f32x4 (&o)[8][2], float (&mrow)[2], float (&lrow)[2]) {
    float tmax[2];
#pragma unroll
    for (int rt = 0; rt < 2; ++rt) { float t = s[0][rt][0];
#pragma unroll
        for (int kt = 0; kt < 4; ++kt)
#pragma unroll
            for (int i = 0; i < 4; ++i) t = fmaxf(t, s[kt][rt][i]);
        tmax[rt] = xmax4(t); }
    const bool keep = ((tmax[0] - mrow[0]) * SM_C2 <= 8.f) && ((tmax[1] - mrow[1]) * SM_C2 <= 8.f);
    if (!__all(keep)) {
#pragma unroll
        for (int rt = 0; rt < 2; ++rt) { const float mnew = fmaxf(mrow[rt], tmax[rt]); const float alpha = __builtin_amdgcn_exp2f((mrow[rt] - mnew) * SM_C2); mrow[rt] = mnew; lrow[rt] *= alpha;
#pragma unroll
            for (int dt = 0; dt < 8; ++dt) o[dt][rt] = o[dt][rt] * alpha; }
    }
#pragma unroll
    for (int rt = 0; rt < 2; ++rt) { const float mc = -mrow[rt] * SM_C2; float ps = 0.f;
#pragma unroll
        for (int kt = 0; kt < 4; ++kt)
#pragma unroll
            for (int i = 0; i < 4; ++i) { const float p = __builtin_amdgcn_exp2f(fmaf(s[kt][rt][i], SM_C2, mc)); s[kt][rt][i] = p; ps += p; }
        lrow[rt] += ps; }
}

__device__ __forceinline__ void attn_prompt_unit(Frame& F, int b, int g, int ti) {
    const int tid_ = fresh_tid(F);
    const int tid = tid_, lane = tid & 63, w = F.wave, idx = lane & 15, q = lane >> 4, head = idx & 3;
    LAS unsigned char* L = F.lds + RING_OFF;
    const float NEG = -__builtin_inff();
    const int t0 = ti * 64, bg = b * NG + g;
    const bf16* Qb = (const bf16*)(F.ws + WS_Q);
    const bf16* KSb = (const bf16*)(F.ws + WS_KS) + (size_t)bg * SEQ * 128;   const bf16* VSb = (const bf16*)(F.ws + WS_VST) + (size_t)bg * 128 * SEQ;
    const bf16* KWb = (const bf16*)(F.ws + WS_KW) + (size_t)bg * SEQ * 128;   const bf16* VWb = (const bf16*)(F.ws + WS_VWT) + (size_t)bg * 128 * SEQ;
    const bf16* KCb = (const bf16*)(F.ws + WS_CMPP) + (size_t)(bg * 2 + 0) * 16384; const bf16* VCb = (const bf16*)(F.ws + WS_CMPP) + (size_t)(bg * 2 + 1) * 16384;
    int qpos[2]; bf16x8 qf[2][4];
    const float* const gbase = (const float*)(F.ws + WS_GATES) + (size_t)b * SEQ * 24 + (4 * g + head) * 3;
#pragma unroll
    for (int rt = 0; rt < 2; ++rt) { qpos[rt] = t0 + 8 * w + 4 * rt + (idx >> 2);
        const size_t grow = (size_t)b * SEQ + qpos[rt];
        const bf16* qp = Qb + grow * 1024 + (4 * g + head) * 128 + 8 * q;
#pragma unroll
        for (int ks = 0; ks < 4; ++ks) qf[rt][ks] = *(const bf16x8*)(qp + 32 * ks);
        }
    LAS unsigned char* const accb = L + AT_ACC + w * 8192 + lane * 8;
    unsigned selmask[2];
    {
        TileRegs R;
        tile_load(R, KCb, VCb, 128, tid); tile_store(R, L + AT_K0, L + AT_V0, tid);
        tile_load(R, KCb + 64 * 128, VCb + 64, 128, tid); tile_store(R, L + AT_K1, L + AT_V1, tid);
        __syncthreads();
        f32x4 s0[4][2], s1[4][2];
        qk_tile(s0, L + AT_K0, qf, idx, q); qk_tile(s1, L + AT_K1, qf, idx, q);
        float inv[2];
#pragma unroll
        for (int rt = 0; rt < 2; ++rt) {
            const int nmax = (qpos[rt] - 31) >> 4;
            float tmax = NEG;
#pragma unroll
            for (int kt = 0; kt < 4; ++kt)
#pragma unroll
                for (int i = 0; i < 4; ++i) { const int n0 = 16 * kt + 4 * q + i, n1 = n0 + 64;
                    const float a = (n0 <= nmax) ? s0[kt][rt][i] * SM_C2 : NEG, c = (n1 <= nmax && n1 < NCMP) ? s1[kt][rt][i] * SM_C2 : NEG;
                    s0[kt][rt][i] = a; s1[kt][rt][i] = c; tmax = fmaxf(tmax, fmaxf(a, c)); }
            tmax = xmax4(tmax);
            const float mx = fmaxf(tmax, -1e30f);
            float ps = 0.f;
#pragma unroll
            for (int kt = 0; kt < 4; ++kt)
#pragma unroll
                for (int i = 0; i < 4; ++i) { const float a = __builtin_amdgcn_exp2f(s0[kt][rt][i] - mx), c = __builtin_amdgcn_exp2f(s1[kt][rt][i] - mx); s0[kt][rt][i] = a; s1[kt][rt][i] = c; ps += a + c; }
            ps = xsum4(ps);
            inv[rt] = ps > 0.f ? 1.f / ps : 1.f;
#pragma unroll
            for (int kt = 0; kt < 4; ++kt) { s0[kt][rt] = s0[kt][rt] * inv[rt]; s1[kt][rt] = s1[kt][rt] * inv[rt]; }
        }
        float G8[2][8], L8[2][8];
#pragma unroll
        for (int rt = 0; rt < 2; ++rt)
#pragma unroll
            for (int kt = 0; kt < 4; ++kt) { G8[rt][kt] = (s0[kt][rt][0] + s0[kt][rt][1]) + (s0[kt][rt][2] + s0[kt][rt][3]); L8[rt][kt] = s0[kt][rt][3];
                                             G8[rt][4 + kt] = (s1[kt][rt][0] + s1[kt][rt][1]) + (s1[kt][rt][2] + s1[kt][rt][3]); L8[rt][4 + kt] = s1[kt][rt][3]; }
        {
            f32x4 o[8][2];
#pragma unroll
            for (int dt = 0; dt < 8; ++dt) { o[dt][0] = (f32x4){0.f, 0.f, 0.f, 0.f}; o[dt][1] = (f32x4){0.f, 0.f, 0.f, 0.f}; }
            pv_tile(o, L + AT_V0, s0, idx, q); pv_tile(o, L + AT_V1, s1, idx, q);
#pragma unroll
            for (int dt = 0; dt < 8; ++dt)
#pragma unroll
                for (int rt = 0; rt < 2; ++rt) { const f32x4 v = o[dt][rt] * gbase[(size_t)qpos[rt] * 24]; u32x2v pk; pk.x = cvtpk(v[0], v[1]); pk.y = cvtpk(v[2], v[3]);
                    *(LAS u32x2v*)(accb + (dt * 2 + rt) * 512) = pk; }
        }
        __builtin_amdgcn_sched_barrier(0);
        LAS float* SC = (LAS float*)(L + AT_SC);
#pragma unroll
        for (int rt = 0; rt < 2; ++rt) {
            float T8[8];
#pragma unroll
            for (int k8 = 0; k8 < 8; ++k8) T8[k8] = from_prev_row(L8[rt][k8], q);
            const int jt = ti;
#pragma unroll
            for (int k8 = 0; k8 < 8; ++k8) {
                const float prev = (k8 > 0) ? T8[k8 > 0 ? k8 - 1 : 0] : 0.f;
                float im = G8[rt][k8] + (q == 0 ? prev : T8[k8]);
                im = quad_sum(im);
                const int sb = 4 * k8 + q;
                const bool force = (sb == 0) | (sb == jt) | (sb == jt - 1);
                const float score = force ? 1e4f : ((sb <= jt) ? im : -1.f);
                SC[(w * 8 + 4 * rt + (idx >> 2)) * 32 + sb] = score;
            }
            __builtin_amdgcn_sched_barrier(0);
        }
        LDS_WAIT(); asm volatile("" ::: "memory");
#pragma unroll
        for (int rt = 0; rt < 2; ++rt) {
            const LAS f32x4* sp = (const LAS f32x4*)(SC + (w * 8 + 4 * rt + (idx >> 2)) * 32);
            float sc[32];
#pragma unroll
            for (int k = 0; k < 8; ++k) { const f32x4 v = sp[k]; sc[4 * k] = v[0]; sc[4 * k + 1] = v[1]; sc[4 * k + 2] = v[2]; sc[4 * k + 3] = v[3]; }
            unsigned mk = 0u;
#pragma unroll
            for (int k8 = 0; k8 < 8; ++k8) {
                const float mine = (q == 0) ? sc[4 * k8] : (q == 1) ? sc[4 * k8 + 1] : (q == 2) ? sc[4 * k8 + 2] : sc[4 * k8 + 3];
                const int sb = 4 * k8 + q;
                int rank = 0;
#pragma unroll
                for (int o2 = 0; o2 < 32; ++o2) rank += ((sc[o2] > mine) | ((sc[o2] == mine) & (o2 < sb))) ? 1 : 0;
                mk |= (rank < TOPK) ? (1u << sb) : 0u;
            }
            mk = xor4(mk);
            selmask[rt] = mk;
            __builtin_amdgcn_sched_barrier(0);
        }
        __syncthreads();
    }
#ifndef PROBE_MODE_LO
#define PROBE_MODE_LO 0
#define PROBE_MODE_HI 2
#endif
    DmaOff DO; dma_setup(DO, w, lane);
#pragma unroll 1
    for (int mode = PROBE_MODE_LO; mode < PROBE_MODE_HI; ++mode) {
        const bf16* Kb = mode ? KWb : KSb; const bf16* Vb = mode ? VWb : VSb;
        const int jlo = mode ? ((ti > 8) ? ti - 8 : 0) : 0, jhi = ti;
        f32x4 o[8][2]; float mrow[2] = {-1e30f, -1e30f}, lrow[2] = {0.f, 0.f};
#pragma unroll
        for (int dt = 0; dt < 8; ++dt) { o[dt][0] = (f32x4){0.f, 0.f, 0.f, 0.f}; o[dt][1] = (f32x4){0.f, 0.f, 0.f, 0.f}; }
        dma_issue(DO, Kb + (size_t)jlo * 64 * 128, Vb + jlo * 64, L + AT_K0, L + AT_V0, w);
        asm volatile("s_waitcnt vmcnt(0)" ::: "memory");
        __syncthreads();
#pragma unroll 1
        for (int j = jlo; j <= jhi; ++j) {
            const int par = (j - jlo) & 1;
            LAS unsigned char* kb = L + (par ? AT_K1 : AT_K0); LAS unsigned char* vb = L + (par ? AT_V1 : AT_V0);
            if (j < jhi) dma_issue(DO, Kb + (size_t)(j + 1) * 64 * 128, Vb + (j + 1) * 64, L + (par ? AT_K0 : AT_K1), L + (par ? AT_V0 : AT_V1), w);
            f32x4 s[4][2];
            qk_tile(s, kb, qf, idx, q);
            VHalf VA; v_prefetch(VA, vb, 0, idx, q);
            const int key0 = 64 * j;
            const bool edge = (j == jhi) || (mode && j == ti - 8);
            if (edge) {
#pragma unroll
                for (int rt = 0; rt < 2; ++rt) {
                    const bool rowok = mode ? true : (((selmask[rt] >> j) & 1u) != 0u);
                    const int lo = mode ? qpos[rt] - (WB - 1) : 0;
#pragma unroll
                    for (int kt = 0; kt < 4; ++kt)
#pragma unroll
                        for (int i = 0; i < 4; ++i) { const int key = key0 + 16 * kt + 4 * q + i;
                            const bool ok = rowok && key <= qpos[rt] && key >= lo;
                            s[kt][rt][i] = ok ? s[kt][rt][i] : NEG; }
                }
            } else if (!mode) {
                const bool ok0 = ((selmask[0] >> j) & 1u) != 0u, ok1 = ((selmask[1] >> j) & 1u) != 0u;
                if (!__all(ok0 && ok1)) {
#pragma unroll
                    for (int kt = 0; kt < 4; ++kt)
#pragma unroll
                        for (int i = 0; i < 4; ++i) { s[kt][0][i] = ok0 ? s[kt][0][i] : NEG; s[kt][1][i] = ok1 ? s[kt][1][i] : NEG; }
                }
            }
            osm_update(s, o, mrow, lrow);
            { bf16x8 pf[2][2]; p_pack(pf, s); pv_half(o, 0, VA, pf); v_prefetch(VA, vb, 1, idx, q); pv_half(o, 4, VA, pf); }
            asm volatile("s_waitcnt vmcnt(0)" ::: "memory");
            __syncthreads();
        }
#pragma unroll
        for (int rt = 0; rt < 2; ++rt) { const float l = xsum4(lrow[rt]);
            const float sc = gbase[(size_t)qpos[rt] * 24 + 1 + mode] * (l > 0.f ? 1.f / l : 1.f);
#pragma unroll
            for (int dt = 0; dt < 8; ++dt) { const f32x4 v = o[dt][rt] * sc;
                LAS u32x2v* op = (LAS u32x2v*)(accb + (dt * 2 + rt) * 512);
                u32x2v pk = *op; pk.x = cvtpk(bf_lo(pk.x) + v[0], bf_hi(pk.x) + v[1]); pk.y = cvtpk(bf_lo(pk.y) + v[2], bf_hi(pk.y) + v[3]); *op = pk; } }
    }
    LDS_WAIT(); asm volatile("" ::: "memory");
    { bf16* CC = (bf16*)(F.ws + WS_CONCAT) + ((size_t)b * SEQ + t0 + 8 * w) * DM + 4 * g * 128 + 8 * lane;
      const int hh = lane >> 4, c16 = lane & 15, dts = c16 >> 1, q0 = 2 * (c16 & 1);
#pragma unroll
      for (int T = 0; T < 8; ++T) { const int rt = T >> 2, tl = T & 3;
          const LAS unsigned char* sp = L + AT_ACC + w * 8192 + ((dts * 2 + rt) * 64 + q0 * 16 + tl * 4 + hh) * 8;
          const u32x2v lo = *(const LAS u32x2v*)sp, hi = *(const LAS u32x2v*)(sp + 128);
          v4u o4; o4.x = lo.x; o4.y = lo.y; o4.z = hi.x; o4.w = hi.y;
          *(v4u*)(CC + (size_t)T * DM) = o4; } }
    LDS_WAIT(); asm volatile("" ::: "memory");
}

constexpr int SA_SCC = 0;
constexpr int SA_SSEL = 2048;
constexpr int SA_SWIN = SA_SSEL + 4 * 964 * 4;
constexpr int SA_RED = SA_SWIN + 4 * 512 * 4;
constexpr int SA_MISC = SA_RED + 8 * 4 * 128 * 4;
constexpr int SA_END = SA_MISC + 1024;
static_assert(SA_END <= RING_BYTES, "sample attention LDS");
constexpr int NSELROWS = 15 * 64 + 1;

__device__ __forceinline__ float dot4(const f32x2v (&q2)[4][4], const f32x4 a, const f32x4 b, int c) {
    const f32x2v a01 = {a[0], a[1]}, a23 = {a[2], a[3]}, b01 = {b[0], b[1]}, b23 = {b[2], b[3]};
    float p[4];
#pragma unroll
    for (int h = 0; h < 4; ++h) { f32x2v t = q2[h][0] * a01; t = q2[h][1] * a23 + t; t = q2[h][2] * b01 + t; t = q2[h][3] * b23 + t; p[h] = t.x + t.y; }
    const bool odd = (c & 1) != 0, hi = (c & 2) != 0;
    const float r0 = (odd ? p[1] : p[0]) + dpp_f<0xB1>(odd ? p[0] : p[1]);
    const float r1 = (odd ? p[3] : p[2]) + dpp_f<0xB1>(odd ? p[2] : p[3]);
    float r = (hi ? r1 : r0) + dpp_f<0x4E>(hi ? r0 : r1);
    r += dpp_f<0x128>(r); r += dpp_f<0x124>(r);
    return r * SM_C2;
}
__device__ __forceinline__ void axpy4(float (&acc)[4][8], const float (&p)[4], const f32x4 a, const f32x4 b) {
#pragma unroll
    for (int h = 0; h < 4; ++h) {
#pragma unroll
        for (int e = 0; e < 4; ++e) { acc[h][e] = fmaf(p[h], a[e], acc[h][e]); acc[h][4 + e] = fmaf(p[h], b[e], acc[h][4 + e]); } }
}

__device__ __forceinline__ void attn_sample_unit(Frame& F, const Args& A, int s, int g) {
    const int tid_ = fresh_tid(F);
    const int tid = tid_, lane = tid & 63, w = F.wave, r = lane >> 4, c = lane & 15;
    LAS unsigned char* L = F.lds + RING_OFF;
    LAS float* SCC = (LAS float*)(L + SA_SCC); LAS float* SSEL = (LAS float*)(L + SA_SSEL); LAS float* SWIN = (LAS float*)(L + SA_SWIN);
    LAS float* RED = (LAS float*)(L + SA_RED); LAS int* BLKROW = (LAS int*)(L + SA_MISC); LAS float* COEF = (LAS float*)(L + SA_MISC + 64); LAS float* SCORE = (LAS float*)(L + SA_MISC + 128);
    const int sg = s * 2 + g;
    const float* cache = A.in[2]; const float* swin = A.in[3]; const int* pt = (const int*)A.in[5];
    const bf16* KC = (const bf16*)(F.ws + WS_CMPS) + (size_t)(sg * 2 + 0) * 16384; const bf16* VC = (const bf16*)(F.ws + WS_CMPS) + (size_t)(sg * 2 + 1) * 16384;
    const float* gates = (const float*)(F.ws + WS_GATES) + (size_t)(NPTOK + s) * 24 + 4 * g * 3;
    float* wout = F.out + O_WINS + (size_t)s * WB * 512;
    const float* knew_sel = F.out + O_KVS + (size_t)s * 1024 + 512 + g * 128;
    f32x2v qv[4][4];
    { const bf16* qp = (const bf16*)(F.ws + WS_Q) + (size_t)(NPTOK + s) * 1024 + 4 * g * 128 + 4 * c;
#pragma unroll
      for (int h = 0; h < 4; ++h) { const u32x2v t0 = *(const u32x2v*)(qp + h * 128), t1 = *(const u32x2v*)(qp + h * 128 + 64);
          qv[h][0] = (f32x2v){bf_lo(t0.x), bf_hi(t0.x)}; qv[h][1] = (f32x2v){bf_lo(t0.y), bf_hi(t0.y)}; qv[h][2] = (f32x2v){bf_lo(t1.x), bf_hi(t1.x)}; qv[h][3] = (f32x2v){bf_lo(t1.y), bf_hi(t1.y)}; } }
#define SA_BAR() do { asm volatile("s_waitcnt lgkmcnt(0)" ::: "memory"); __builtin_amdgcn_s_barrier(); asm volatile("" ::: "memory"); } while (0)
    f32x4 ra[8], rb[8];
#define WK_LOAD(grp0_, kind_) do { _Pragma("unroll") for (int u = 0; u < 8; ++u) { const int rho_ = 4 * ((grp0_) + 8 * u) + r; \
        const float* src = (rho_ < 511) ? swin + ((size_t)(s * WB + rho_ + 1) * 2 + (kind_)) * 256 + g * 128 + 4 * c : wout + ((size_t)511 * 2 + (kind_)) * 256 + g * 128 + 4 * c; \
        ra[u] = __builtin_nontemporal_load((const f32x4*)src); rb[u] = __builtin_nontemporal_load((const f32x4*)(src + 64)); } } while (0)
#define WK_COPY(grp0_, kind_) do { _Pragma("unroll") for (int u = 0; u < 8; ++u) { const int rho_ = 4 * ((grp0_) + 8 * u) + r; \
        if (rho_ < 511) { float* dst = wout + ((size_t)rho_ * 2 + (kind_)) * 256 + g * 128 + 4 * c; *(f32x4*)dst = ra[u]; *(f32x4*)(dst + 64) = rb[u]; } } } while (0)
#define SV_LOAD(grp0_) do { _Pragma("unroll") for (int u = 0; u < 8; ++u) { const int rho_ = 4 * ((grp0_) + 8 * u) + r; \
        const float* src = knew_sel + 256 + 4 * c; \
        if (rho_ < 960) src = cache + ((size_t)(BLKROW[rho_ >> 6] + (rho_ & 63))) * 1024 + 768 + g * 128 + 4 * c; \
        ra[u] = __builtin_nontemporal_load((const f32x4*)src); rb[u] = __builtin_nontemporal_load((const f32x4*)(src + 64)); } } while (0)
    WK_LOAD(w, 0);
    for (int grp = w; grp < 32; grp += 8) { const int n = 4 * grp + r;
        const u32x2v t0 = *(const u32x2v*)(KC + (size_t)n * 128 + 4 * c), t1 = *(const u32x2v*)(KC + (size_t)n * 128 + 64 + 4 * c);
        const f32x4 a = {bf_lo(t0.x), bf_hi(t0.x), bf_lo(t0.y), bf_hi(t0.y)}, b = {bf_lo(t1.x), bf_hi(t1.x), bf_lo(t1.y), bf_hi(t1.y)};
        const float sc = dot4(qv, a, b, c);
        if (c < 4) SCC[c * 128 + n] = sc; }
    SA_BAR();
    if (w < 4) { const int h = w;
        const float a = SCC[h * 128 + lane], b = (lane + 64 < NCMP) ? SCC[h * 128 + 64 + lane] : -__builtin_inff();
        const float mx = wave_max(fmaxf(a, b));
        const float ea = __builtin_amdgcn_exp2f(a - mx), eb = __builtin_amdgcn_exp2f(b - mx);
        const float inv = 1.f / wave_sum(ea + eb);
        SCC[h * 128 + lane] = ea * inv; SCC[h * 128 + 64 + lane] = eb * inv; }
    SA_BAR();
    if (w == 0) {
        const int sb = lane;
        float im = 0.f;
        if (sb < NSEL_S) {
#pragma unroll
            for (int k = -1; k < 4; ++k) { const int n = 4 * sb + k; if (n >= 0 && n < NCMP) im += (SCC[n] + SCC[128 + n]) + (SCC[256 + n] + SCC[384 + n]); } }
        const bool force = (sb == 0) || (sb == 32) || (sb == 31);
        const float score = (sb < NSEL_S) ? (force ? 1e4f : im) : -2.f;
        SCORE[lane] = score;
        LDS_WAIT(); asm volatile("" ::: "memory");
        int rank = 0;
        for (int o = 0; o < NSEL_S; ++o) { const float v = SCORE[o]; rank += (v > score || (v == score && o < sb)) ? 1 : 0; }
        const bool sel = (sb < 32) && (rank < TOPK);
        const unsigned long long bm = __ballot(sel);
        const int posn = __popcll(bm & ((1ull << sb) - 1ull));
        if (sel && posn < 15) BLKROW[posn] = pt[s * NPAGES + (sb >> 1)] * PAGE + (sb & 1) * 64;
        if (lane < 12) { const int h = lane / 3, br = lane % 3; if (br == 0) COEF[h] = gates[h * 3]; }
    }
    SA_BAR();
    for (int grp0 = w; grp0 < 128; grp0 += 64) {
        if (grp0 != w) WK_LOAD(grp0, 0);
        WK_COPY(grp0, 0);
#pragma unroll
        for (int u = 0; u < 8; ++u) { const int rho_ = 4 * (grp0 + 8 * u) + r; const float sc = dot4(qv, ra[u], rb[u], c);
            if (c < 4) SWIN[c * 512 + rho_] = sc; }
    }
    for (int grp0 = w; grp0 < 241; grp0 += 64) {
        int rho[8];
#pragma unroll
        for (int u = 0; u < 8; ++u) { const int grp = grp0 + 8 * u; rho[u] = 4 * grp + r;
            const float* src = knew_sel + 4 * c;
            if (rho[u] < 960) src = cache + ((size_t)(BLKROW[rho[u] >> 6] + (rho[u] & 63))) * 1024 + 512 + g * 128 + 4 * c;
            ra[u] = __builtin_nontemporal_load((const f32x4*)src); rb[u] = __builtin_nontemporal_load((const f32x4*)(src + 64)); }
#pragma unroll
        for (int u = 0; u < 8; ++u) { const float sc = dot4(qv, ra[u], rb[u], c);
            if (c < 4 && rho[u] < NSELROWS && grp0 + 8 * u < 241) SSEL[c * 964 + rho[u]] = sc; }
    }
    SV_LOAD(w);
    SA_BAR();
    { const int br = w >> 2, h = w & 3, n = br ? 512 : NSELROWS; LAS float* P = br ? SWIN + h * 512 : SSEL + h * 964;
      float mx = -__builtin_inff();
      for (int i = lane; i < n; i += 64) mx = fmaxf(mx, P[i]);
      mx = wave_max(mx);
      float sum = 0.f;
      for (int i = lane; i < n; i += 64) { const float e = __builtin_amdgcn_exp2f(P[i] - mx); P[i] = e; sum += e; }
      sum = wave_sum(sum);
      if (lane == 0) COEF[(1 + br) * 4 + h] = gates[h * 3 + 1 + br] / sum; }
    SA_BAR();
    float acc[4][8];
#pragma unroll
    for (int h = 0; h < 4; ++h)
#pragma unroll
        for (int e = 0; e < 8; ++e) acc[h][e] = 0.f;
    { float cf[4];
#pragma unroll
      for (int h = 0; h < 4; ++h) cf[h] = COEF[4 + h];
      for (int grp0 = w; grp0 < 241; grp0 += 64) {
          if (grp0 != w) SV_LOAD(grp0);
#pragma unroll
          for (int u = 0; u < 8; ++u) { float p[4]; const int rho_ = 4 * (grp0 + 8 * u) + r; const bool ok = rho_ < NSELROWS && grp0 + 8 * u < 241;
#pragma unroll
              for (int h = 0; h < 4; ++h) p[h] = ok ? SSEL[h * 964 + rho_] * cf[h] : 0.f;
              axpy4(acc, p, ra[u], rb[u]); } } }
    { float cf[4];
#pragma unroll
      for (int h = 0; h < 4; ++h) cf[h] = COEF[h];
      for (int grp = w; grp < 32; grp += 8) { const int n = 4 * grp + r;
          const u32x2v t0 = *(const u32x2v*)(VC + (size_t)n * 128 + 4 * c), t1 = *(const u32x2v*)(VC + (size_t)n * 128 + 64 + 4 * c);
          const f32x4 a = {bf_lo(t0.x), bf_hi(t0.x), bf_lo(t0.y), bf_hi(t0.y)}, b = {bf_lo(t1.x), bf_hi(t1.x), bf_lo(t1.y), bf_hi(t1.y)};
          float p[4];
#pragma unroll
          for (int h = 0; h < 4; ++h) p[h] = SCC[h * 128 + n] * cf[h];
          axpy4(acc, p, a, b); } }
    { float cf[4];
#pragma unroll
      for (int h = 0; h < 4; ++h) cf[h] = COEF[8 + h];
      for (int grp0 = w; grp0 < 128; grp0 += 64) {
          WK_LOAD(grp0, 1);
          WK_COPY(grp0, 1);
#pragma unroll
          for (int u = 0; u < 8; ++u) { float p[4]; const int rho_ = 4 * (grp0 + 8 * u) + r;
#pragma unroll
              for (int h = 0; h < 4; ++h) p[h] = SWIN[h * 512 + rho_] * cf[h];
              axpy4(acc, p, ra[u], rb[u]); } } }
#pragma unroll
    for (int h = 0; h < 4; ++h)
#pragma unroll
        for (int e = 0; e < 8; ++e) acc[h][e] = xsum4(acc[h][e]);
    if (r == 0) {
#pragma unroll
        for (int h = 0; h < 4; ++h) { LAS f32x4* d = (LAS f32x4*)(RED + (w * 4 + h) * 128 + 4 * c);
            d[0] = (f32x4){acc[h][0], acc[h][1], acc[h][2], acc[h][3]}; d[16] = (f32x4){acc[h][4], acc[h][5], acc[h][6], acc[h][7]}; } }
    __syncthreads();
    { float v = 0.f;
#pragma unroll
      for (int ww = 0; ww < 8; ++ww) v += RED[ww * 512 + tid];
      bf16* CC = (bf16*)(F.ws + WS_CONCAT) + (size_t)(NPTOK + s) * DM + 4 * g * 128;
      CC[tid] = (bf16)(cvtpk(v, 0.f) & 0xffffu); }
    __syncthreads();
}
#undef WK_LOAD
#undef WK_COPY
#undef SV_LOAD
#undef SA_BAR

#ifndef P4_ORDER
#define P4_ORDER 2
#endif
#ifndef FUSED_NORM
#define FUSED_NORM 0
#endif
#ifndef MK_N_LAUNCHES
#define MK_N_LAUNCHES 1
#endif
constexpr int N_PHASES = 10;
constexpr int N_LAUNCHES = MK_N_LAUNCHES;

__global__ void __launch_bounds__(NTHREADS, 2) nsa_fwd(Args args) {
    extern __shared__ __attribute__((aligned(16))) unsigned char lds[];
    Frame F;
    F.lds = (LAS unsigned char*)lds;
    F.MISC = (volatile LAS unsigned*)(F.lds + MISC_OFF);
    F.tid = threadIdx.x; F.lane = F.tid & 63; F.wave = __builtin_amdgcn_readfirstlane(F.tid >> 6);
    F.G = gridDim.x; { const int bx = blockIdx.x; F.vcu = (F.G % 8 == 0) ? (bx % 8) * (F.G / 8) + bx / 8 : bx; }
    F.ws = args.ws; F.out = args.out;
    F.ctl = (gu32*)(args.ws + WS_CTL);
    for (int u = F.tid; u < (LDS_BYTES - LDSCTL_OFF) / 4; u += NTHREADS) ((LAS unsigned*)(F.lds + LDSCTL_OFF))[u] = 0u;
    __syncthreads();
    XcdBarrier bar; bar.bar = (unsigned*)(F.ctl + CW_BAR); bar.x = 0; bar.st = nullptr;
    if (N_LAUNCHES == 1) bar = xcd_barrier_post((unsigned*)(F.ctl + CW_BAR), F.MISC + 8);
#define GRID_BAR() do { if (N_LAUNCHES == 1) xcd_barrier(bar); } while (0)
    const int lo = args.ph_lo, hi = args.ph_hi;
#ifndef PH_MASK
#define PH_MASK 0x3ff
#endif
#define IN(k) ((((PH_MASK) >> (k)) & 1) && lo <= (k) && (k) < hi)
#define BOTH(k) (IN(k) && IN((k) + 1))
#ifndef PH_REPEAT
#define PH_REPEAT 0
#endif
#define NREP(k) ((((PH_REPEAT) >> (k)) & 1) ? 2 : 1)

    if (IN(0)) { p0_prologue(F, args); if (BOTH(0)) GRID_BAR(); }

    if (IN(1)) {
        if (F.vcu == 0 && F.tid < 256) { const float* part = (const float*)(F.ws + WS_CBPART) + (size_t)(F.tid >> 7) * 64 * 128 + (F.tid & 127); float s = 0.f;
            for (int p = 0; p < 64; ++p) s += part[p * 128];
            ((float*)(F.ws + WS_CBIAS))[F.tid] = s; }
        if ((blockIdx.x & 1) && args.rep != 1) cmps_fused_phase(F, args, F.vcu, F.G);
        if (args.rep != 2)
        { pg8::Gemm g{(const bf16*)(F.ws + WS_XN), (const bf16*)(F.ws + WS_WIN_T), DM, DM, DM}; pg8::StaticOrder S; S.init(MROWS, NPROJ_PAD, F.G, (int)blockIdx.x);
          EpiProj E{F.ws, F.out, (const float*)(F.ws + WS_ROPE)};
          pg8::gemm_phase<EpiProj, pg8::StaticOrder, true>(F.lds + RING_OFF, g, S, E); }
        if (!(blockIdx.x & 1) && args.rep != 1) cmps_fused_phase(F, args, F.vcu, F.G);
        if (BOTH(1)) GRID_BAR();
    }

    if (IN(2)) {
#ifndef SKIP_A
        if ((args.rep == 0 || args.rep == 1) && (F.vcu & 15) == 0) { const int u16 = F.vcu >> 4; cmpp_fused_unit(F, u16 >> 1, u16 & 1); }
#endif
#ifndef SKIP_B
        if (args.rep == 0 || args.rep == 2) cmp2_phase(F, 0, 512);
#endif
#ifndef SKIP_C
        if (args.rep == 0 || args.rep == 3) pool_phase(F, args, (unsigned*)(F.ctl + CW_QT + 256 * args.pad + 128));
#endif
        p0_transposes_dyn(F, args, TI_SMALL, TI_ALL, (unsigned*)(F.ctl + CW_QT + 256 * args.pad));
        if (BOTH(2)) GRID_BAR();
    }


    if (IN(4)) {
#ifdef PROBE_COPY
        { const bf16* src = (const bf16*)(F.ws + PROBE_COPY_SRC); for (int i = F.vcu * NTHREADS + F.tid; i < PROBE_COPY_N; i += F.G * NTHREADS) F.out[i] = bf2f(src[i]); }
#endif
#ifdef PROBE_COPYF
        { const float* src = (const float*)(F.ws + PROBE_COPYF_SRC); for (int i = F.vcu * NTHREADS + F.tid; i < PROBE_COPYF_N; i += F.G * NTHREADS) F.out[i] = src[i]; }
#endif
        bool first = ((int)blockIdx.x >> 3) < 16 && F.G == 256;
        for (;;) {
            int item;
            if (first) item = ((int)blockIdx.x >> 3) * 8 + ((int)blockIdx.x & 7);
            else {
                if (F.tid == 0) F.MISC[0] = __hip_atomic_fetch_add((unsigned*)(F.ctl + CW_Q3 + 64 * args.pad), 1u, __ATOMIC_RELAXED, __HIP_MEMORY_SCOPE_AGENT);
                __syncthreads();
                item = __builtin_amdgcn_readfirstlane((int)F.MISC[0]) + (F.G == 256 ? 128 : 0);
                __syncthreads();
            }
            first = false;
            if (item >= 512) break;
            int pi = -1, si = -1;
#if P4_ORDER == 1
            if (item < 128) pi = item; else if (item < 448) { const int r = item - 128; if (r % 5 == 4) pi = 128 + r / 5; else si = r - r / 5; } else pi = 192 + (item - 448);
#elif P4_ORDER == 3
            if (item < 64) pi = item; else if (item < 320) si = item - 64; else pi = item - 256;
#elif P4_ORDER == 2
            if (item < 128) pi = item; else if (item < 384) si = item - 128; else pi = item - 256;
#else
            if ((item & 1) == 0) pi = item >> 1; else si = item >> 1;
#endif
#ifndef SKIP_D
            if (pi >= 0 && args.rep != 2) { const int ti = 31 - (pi >> 3), bg = pi & 7; attn_prompt_unit(F, bg >> 1, bg & 1, ti); }
#endif
#ifndef SKIP_E
            if (si >= 0 && args.rep != 1) { attn_sample_unit(F, args, si >> 1, si & 1); }
#endif
        }
        if (BOTH(4)) GRID_BAR();
    }

    if (IN(5)) {
        pg8::Gemm g{(const bf16*)(F.ws + WS_CONCAT), (const bf16*)(F.ws + WS_WO_T), DM, DM, DM}; pg8::StaticOrder S; S.init(NPTOK, DM, F.G, (int)blockIdx.x);
#if FUSED_NORM
        EpiWoFused E{args.in[0], args.in[17], F.out + O_YP, (bf16*)(F.ws + WS_XN),
                     RowExch{(unsigned*)(F.ws + WS_XCH), (unsigned*)(F.ctl + CW_XC), (unsigned*)(F.ctl + CW_TMO)}, RowExch{(unsigned*)(F.ws + WS_XCH + 256 * 1024), (unsigned*)(F.ctl + CW_XC + 4096), (unsigned*)(F.ctl + CW_TMO)}};
        pg8::gemm_phase<EpiWoFused, pg8::StaticOrder, false>(F.lds + RING_OFF, g, S, E);
#else
        EpiBf E{(bf16*)(F.ws + WS_M)};
        pg8::gemm_phase<EpiBf, pg8::StaticOrder, true>(F.lds + RING_OFF, g, S, E);
#endif
        skinny_gemm<1, 8>(F, (const bf16*)(F.ws + WS_CONCAT) + (size_t)NPTOK * DM, (const bf16*)(F.ws + WS_WO_T), DM, DM, SkBf{(bf16*)(F.ws + WS_M) + (size_t)NPTOK * DM, DM});
        if (BOTH(5)) GRID_BAR();
    }

    if (IN(6)) { p5_rows(F, args, FUSED_NORM ? NPTOK : 0); if (BOTH(6)) GRID_BAR();
#ifdef EXTRA_BARS
        for (int xb = 0; xb < EXTRA_BARS; ++xb) GRID_BAR();
#endif
    }

    if (IN(7)) {
        pg8::Gemm g{(const bf16*)(F.ws + WS_XN), (const bf16*)(F.ws + WS_WUP_T), DM, DM, DM}; pg8::StaticOrder S; S.init(NPTOK, DFF, F.G, (int)blockIdx.x);
        EpiUp E{(bf16*)(F.ws + WS_ACT)};
        pg8::gemm_phase<EpiUp, pg8::StaticOrder, true>(F.lds + RING_OFF, g, S, E);
        skinny_gemm<4, 4>(F, (const bf16*)(F.ws + WS_XN) + (size_t)NPTOK * DM, (const bf16*)(F.ws + WS_WUP_T), DM, DFF, SkUp{(bf16*)(F.ws + WS_ACT) + (size_t)NPTOK * DFF});
        if (BOTH(7)) GRID_BAR();
    }

    if (IN(8)) {
        pg8::Gemm g{(const bf16*)(F.ws + WS_ACT), (const bf16*)(F.ws + WS_WDN_T), DFF, DFF, DFF}; pg8::StaticOrder S; S.init(NPTOK, DM, F.G, (int)blockIdx.x);
#if FUSED_NORM
        EpiDownFused E{args.in[21], F.out + O_YP, RowExch{(unsigned*)(F.ws + WS_XCH + 512 * 1024), (unsigned*)(F.ctl + CW_XC + 8192), (unsigned*)(F.ctl + CW_TMO)}};
        pg8::gemm_phase<EpiDownFused, pg8::StaticOrder, false>(F.lds + RING_OFF, g, S, E);
#else
        EpiBf E{(bf16*)(F.ws + WS_M2)};
        pg8::gemm_phase<EpiBf, pg8::StaticOrder, true>(F.lds + RING_OFF, g, S, E);
#endif
        skinny_gemm<1, 8>(F, (const bf16*)(F.ws + WS_ACT) + (size_t)NPTOK * DFF, (const bf16*)(F.ws + WS_WDN_T), DFF, DM, SkBf{(bf16*)(F.ws + WS_M2) + (size_t)NPTOK * DM, DM});
        if (BOTH(8)) GRID_BAR();
    }

    if (IN(9)) { p8_rows(F, args, FUSED_NORM ? NPTOK : 0); }
#undef IN
#undef BOTH
#undef GRID_BAR
}

extern "C" void kernel_launch(void* const* d_in, const int* in_sizes, int n_in, void* d_out, int out_size, void* d_ws, size_t ws_size, hipStream_t stream) {
    static int grid = 0;
    if (grid == 0) {
        if (n_in != 22 || ws_size < WS_END) { fprintf(stderr, "kernel_launch: unexpected shapes (n_in %d, out %d, ws %zu); nothing launched\n", n_in, out_size, ws_size); grid = -1; return; }
        int dev = 0, cus = 0, per_cu = 0;
        if (hipGetDevice(&dev) != hipSuccess || hipDeviceGetAttribute(&cus, hipDeviceAttributeMultiprocessorCount, dev) != hipSuccess) { grid = -1; return; }
        if (hipFuncSetAttribute((const void*)nsa_fwd, hipFuncAttributeMaxDynamicSharedMemorySize, LDS_BYTES) != hipSuccess) { fprintf(stderr, "kernel_launch: hipFuncSetAttribute failed\n"); grid = -1; return; }
        if (hipOccupancyMaxActiveBlocksPerMultiprocessor(&per_cu, (const void*)nsa_fwd, NTHREADS, LDS_BYTES) != hipSuccess || per_cu < 1)
            fprintf(stderr, "kernel_launch: note: occupancy query reports %d workgroups per CU\n", per_cu);
        (void)hipGetLastError();
        grid = cus;
        if (grid != 256) { fprintf(stderr, "kernel_launch: %d CUs; the fused norm epilogues need exactly 256 resident workgroups (one 256x256 unit each); nothing launched\n", grid); grid = -1; return; }
    }
    if (grid < 0) return;
    if (hipMemsetAsync((char*)d_ws + WS_CTL, 0, FUSED_NORM ? CTL_ZERO_BYTES : 64 * 1024, stream) != hipSuccess) { fprintf(stderr, "kernel_launch: memset failed\n"); return; }
    Args a{};
    for (int i = 0; i < 22; ++i) a.in[i] = (const float*)d_in[i];
    a.out = (float*)d_out; a.ws = (unsigned char*)d_ws;
    for (int li = 0; li < N_LAUNCHES; ++li) {
        a.ph_lo = (N_LAUNCHES == 1) ? 0 : li; a.ph_hi = (N_LAUNCHES == 1) ? N_PHASES : li + 1; a.rep = 0; a.pad = 0;
        hipLaunchKernelGGL(nsa_fwd, dim3(grid), dim3(NTHREADS), LDS_BYTES, stream, a);
#ifdef REPEAT_LAUNCH
        if (N_LAUNCHES > 1 && li == REPEAT_LAUNCH) { for (int r = 1; r <= REPEAT_TIMES; ++r) { a.rep = REPEAT_KIND; a.pad = r; hipLaunchKernelGGL(nsa_fwd, dim3(grid), dim3(NTHREADS), LDS_BYTES, stream, a); } }
#endif
#ifdef EMPTY_LAUNCHES
        if (N_LAUNCHES > 1 && li == 5) { Args e = a; e.ph_lo = 10; e.ph_hi = 10; for (int r = 0; r < EMPTY_LAUNCHES; ++r) hipLaunchKernelGGL(nsa_fwd, dim3(grid), dim3(NTHREADS), LDS_BYTES, stream, e); }
#endif
        const hipError_t le = hipPeekAtLastError();
        if (le != hipSuccess) { fprintf(stderr, "kernel_launch: launch %d failed: %s\n", li, hipGetErrorName(le)); break; }
    }
}
```
